# Optimizing an MI355X kernel written in HIP

```python
import math
import jax
import jax.numpy as jnp
from jax import lax
import numpy as np

D_MODEL = 1024
BATCH = 4
SEQ = 4096
DEPTH = 4

CHUNK = 64
Q_BLOCK = 128
D_FF = 2816
RMS_EPS = 1e-6
NEG_INF = -1e30

DIFF_HEADS = 4
DIFF_QK_DIM = 64
DIFF_V_DIM = 2 * DIFF_QK_DIM
SB_HEADS = 4
SB_HEAD_DIM = 128
DIFF_Q_COLS = DIFF_HEADS * 2 * DIFF_QK_DIM
DIFF_V_COLS = DIFF_HEADS * DIFF_V_DIM
SB_COLS = SB_HEADS * SB_HEAD_DIM
ATT_IN_DIM = 2 * DIFF_Q_COLS + DIFF_V_COLS + 3 * SB_COLS
ATT_MIX_DIM = DIFF_V_COLS + SB_COLS

GDN_HEADS = 8
GDN_HEAD_DIM = 128
GDN_CONV = 4
GDN_MIX_DIM = GDN_HEADS * GDN_HEAD_DIM
GDN_QKV_DIM = 3 * GDN_MIX_DIM
GDN_IN_DIM = GDN_QKV_DIM + GDN_MIX_DIM + 2 * GDN_HEADS

N_EVEN = (DEPTH + 1) // 2
N_ODD = DEPTH // 2

kernel_name = 'hybrid_streaming_diff_sb_gdn'


def rms_norm(x, w):
    x32 = x.astype(jnp.float32)
    y = x32 * lax.rsqrt(jnp.mean(x32 * x32, axis=-1, keepdims=True) + RMS_EPS)
    return (y * w.astype(jnp.float32)).astype(x.dtype)


def swiglu(h, w_gate, w_up, w_down):
    return (jax.nn.silu(h @ w_gate) * (h @ w_up)) @ w_down


def l2_normalize(x):
    return x * lax.rsqrt(jnp.sum(x * x, axis=-1, keepdims=True) + 1e-6)


def diff_attention(q, k, v, lam, slopes):
    b, s_len, h, _, _ = q.shape
    scale = DIFF_QK_DIM ** -0.5
    pos_k = jnp.arange(s_len)

    def block(i):
        start = i * Q_BLOCK
        qb = lax.dynamic_slice_in_dim(q, start, Q_BLOCK, axis=1)
        pos_q = start + jnp.arange(Q_BLOCK)
        dist = jnp.abs(pos_q[:, None] - pos_k[None, :]).astype(jnp.float32)
        allowed = (pos_k[None, :] // CHUNK) <= (pos_q[:, None] // CHUNK)
        bias = jnp.where(allowed, -slopes[:, None, None] * dist, NEG_INF)
        scores = jnp.einsum('bqhcd,bkhcd->bchqk', qb, k) * scale + bias
        p = jax.nn.softmax(scores, axis=-1)
        weights = p[:, 0] - lam * p[:, 1]
        return jnp.einsum('bhqk,bkhd->bqhd', weights, v)

    out = lax.map(block, jnp.arange(s_len // Q_BLOCK))
    return out.transpose(1, 0, 2, 3, 4).reshape(b, s_len, h, v.shape[-1])


def stick_breaking_attention(q, k, v):
    b, s_len, h, d = q.shape
    scale = SB_HEAD_DIM ** -0.5
    pos_k = jnp.arange(s_len)

    def block(i):
        start = i * Q_BLOCK
        qb = lax.dynamic_slice_in_dim(q, start, Q_BLOCK, axis=1)
        pos_q = start + jnp.arange(Q_BLOCK)
        earlier = pos_k[None, :] < pos_q[:, None]
        z = jnp.einsum('bqhd,bkhd->bhqk', qb, k) * scale
        log_beta = jax.nn.log_sigmoid(z)
        log_keep = jnp.where(earlier, jax.nn.log_sigmoid(-z), 0.0)
        log_after = lax.cumsum(log_keep, axis=3, reverse=True) - log_keep
        a = jnp.where(earlier, jnp.exp(log_beta + log_after), 0.0)
        return jnp.einsum('bhqk,bkhd->bqhd', a, v)

    out = lax.map(block, jnp.arange(s_len // Q_BLOCK))
    return out.transpose(1, 0, 2, 3, 4).reshape(b, s_len, h, d)


def causal_depthwise_conv(x, w):
    taps = w.shape[0]
    s_len = x.shape[1]
    xp = jnp.pad(x, ((0, 0), (taps - 1, 0), (0, 0)))
    y = xp[:, 0:s_len] * w[0]
    for i in range(1, taps):
        y = y + xp[:, i:i + s_len] * w[i]
    return y


def gated_delta_rule_chunked(q, k, v, g, beta):
    b, s_len, h, dk = q.shape
    dv = v.shape[-1]
    n_chunks = s_len // CHUNK

    def to_chunks(t):
        t = t.reshape((b, n_chunks, CHUNK, h) + t.shape[3:])
        return jnp.moveaxis(t, 3, 1)

    q = to_chunks(q * dk ** -0.5)
    k = to_chunks(k)
    v = to_chunks(v)
    g = to_chunks(g)
    beta = to_chunks(beta)
    gc = jnp.cumsum(g, axis=-1)
    incl = jnp.tril(jnp.ones((CHUNK, CHUNK), dtype=bool))
    strict = jnp.tril(jnp.ones((CHUNK, CHUNK), dtype=bool), -1)
    decay = jnp.exp(jnp.where(incl, gc[..., :, None] - gc[..., None, :], -jnp.inf))
    kb = k * beta[..., None]
    vb = v * beta[..., None]
    l_mat = jnp.where(strict, jnp.einsum('bhncd,bhnsd->bhncs', kb, k) * decay, 0.0)
    eye = jnp.eye(CHUNK, dtype=q.dtype)
    t_mat = lax.linalg.triangular_solve(l_mat + eye, jnp.broadcast_to(eye, l_mat.shape),
                                        left_side=True, lower=True, unit_diagonal=True)
    u = jnp.einsum('bhncs,bhnsd->bhncd', t_mat, vb)
    w = jnp.einsum('bhncs,bhnsd->bhncd', t_mat, kb * jnp.exp(gc)[..., None])
    a_qk = jnp.where(incl, jnp.einsum('bhncd,bhnsd->bhncs', q, k) * decay, 0.0)
    q_dec = q * jnp.exp(gc)[..., None]
    k_dec = k * jnp.exp(gc[..., -1:] - gc)[..., None]
    chunk_decay = jnp.exp(gc[..., -1])
    xs = (jnp.moveaxis(q_dec, 2, 0), jnp.moveaxis(k_dec, 2, 0), jnp.moveaxis(u, 2, 0),
          jnp.moveaxis(w, 2, 0), jnp.moveaxis(a_qk, 2, 0), jnp.moveaxis(chunk_decay, 2, 0))

    def step(state, inp):
        qd, kd, un, wn, aqk, cd = inp
        v_new = un - jnp.einsum('bhcd,bhde->bhce', wn, state)
        o = jnp.einsum('bhcd,bhde->bhce', qd, state) + jnp.einsum('bhcs,bhse->bhce', aqk, v_new)
        state = state * cd[..., None, None] + jnp.einsum('bhcd,bhce->bhde', kd, v_new)
        return state, o

    state0 = jnp.zeros((b, h, dk, dv), dtype=q.dtype)
    _, out = lax.scan(step, state0, xs)
    return out.transpose(1, 0, 3, 2, 4).reshape(b, s_len, h, dv)


def even_mixer(h, w_in, diff_lambda, diff_subln, w_out, layer_idx):
    b, s_len, _ = h.shape
    proj = (h @ w_in).astype(jnp.float32)
    splits = [DIFF_Q_COLS, 2 * DIFF_Q_COLS, 2 * DIFF_Q_COLS + DIFF_V_COLS,
              2 * DIFF_Q_COLS + DIFF_V_COLS + SB_COLS, 2 * DIFF_Q_COLS + DIFF_V_COLS + 2 * SB_COLS]
    qa, ka, va, qs, ks, vs = jnp.split(proj, splits, axis=-1)
    qa = qa.reshape(b, s_len, DIFF_HEADS, 2, DIFF_QK_DIM)
    ka = ka.reshape(b, s_len, DIFF_HEADS, 2, DIFF_QK_DIM)
    va = va.reshape(b, s_len, DIFF_HEADS, DIFF_V_DIM)
    qs = qs.reshape(b, s_len, SB_HEADS, SB_HEAD_DIM)
    ks = ks.reshape(b, s_len, SB_HEADS, SB_HEAD_DIM)
    vs = vs.reshape(b, s_len, SB_HEADS, SB_HEAD_DIM)
    lambda_init = 0.8 - 0.6 * math.exp(-0.3 * layer_idx)
    lp = diff_lambda.astype(jnp.float32)
    lam = jnp.exp(jnp.sum(lp[0] * lp[1])) - jnp.exp(jnp.sum(lp[2] * lp[3])) + lambda_init
    slopes = 2.0 ** (-8.0 * jnp.arange(1, DIFF_HEADS + 1, dtype=jnp.float32) / DIFF_HEADS)
    oa = diff_attention(qa, ka, va, lam, slopes)
    oa = rms_norm(oa, diff_subln) * (1.0 - lambda_init)
    osb = stick_breaking_attention(qs, ks, vs)
    o = jnp.concatenate([oa.reshape(b, s_len, DIFF_V_COLS), osb.reshape(b, s_len, SB_COLS)], axis=-1)
    return o.astype(h.dtype) @ w_out


def odd_mixer(h, w_in, conv_w, a_log, dt_bias, norm_w, w_out):
    b, s_len, _ = h.shape
    proj = h @ w_in
    qkv, gate, b_raw, a_raw = jnp.split(
        proj, [GDN_QKV_DIM, GDN_QKV_DIM + GDN_MIX_DIM, GDN_QKV_DIM + GDN_MIX_DIM + GDN_HEADS], axis=-1)
    qkv = jax.nn.silu(causal_depthwise_conv(qkv, conv_w)).astype(jnp.float32)
    q, k, v = jnp.split(qkv, 3, axis=-1)
    q = l2_normalize(q.reshape(b, s_len, GDN_HEADS, GDN_HEAD_DIM))
    k = l2_normalize(k.reshape(b, s_len, GDN_HEADS, GDN_HEAD_DIM))
    v = v.reshape(b, s_len, GDN_HEADS, GDN_HEAD_DIM)
    beta = jax.nn.sigmoid(b_raw.astype(jnp.float32))
    g = -jnp.exp(a_log.astype(jnp.float32)) * jax.nn.softplus(
        a_raw.astype(jnp.float32) + dt_bias.astype(jnp.float32))
    o = gated_delta_rule_chunked(q, k, v, g, beta)
    o = rms_norm(o, norm_w) * jax.nn.silu(gate.astype(jnp.float32).reshape(b, s_len, GDN_HEADS, GDN_HEAD_DIM))
    return o.reshape(b, s_len, GDN_MIX_DIM).astype(h.dtype) @ w_out


def setup_inputs(seed: int = 0) -> dict:
    key = jax.random.key(seed)
    ks = jax.random.split(key, 24)
    f32 = jnp.float32

    def dense(k, shape, fan_in):
        return jax.random.normal(k, shape, f32) * fan_in ** -0.5

    def gain(k, shape):
        return 1.0 + 0.02 * jax.random.normal(k, shape, f32)

    x = jax.random.normal(ks[0], (BATCH, SEQ, D_MODEL), f32)
    ffn1_norm = gain(ks[1], (DEPTH, D_MODEL))
    ffn1_w_gate = dense(ks[2], (DEPTH, D_MODEL, D_FF), D_MODEL)
    ffn1_w_up = dense(ks[3], (DEPTH, D_MODEL, D_FF), D_MODEL)
    ffn1_w_down = dense(ks[4], (DEPTH, D_FF, D_MODEL), D_FF)
    mix_norm = gain(ks[5], (DEPTH, D_MODEL))
    att_w_in = dense(ks[6], (N_EVEN, D_MODEL, ATT_IN_DIM), D_MODEL)
    diff_lambda = 0.1 * jax.random.normal(ks[7], (N_EVEN, 4, DIFF_QK_DIM), f32)
    diff_subln = gain(ks[8], (N_EVEN, DIFF_V_DIM))
    att_w_out = dense(ks[9], (N_EVEN, ATT_MIX_DIM, D_MODEL), ATT_MIX_DIM)
    gdn_w_in = dense(ks[10], (N_ODD, D_MODEL, GDN_IN_DIM), D_MODEL)
    gdn_conv_w = dense(ks[11], (N_ODD, GDN_CONV, GDN_QKV_DIM), GDN_CONV)
    gdn_a_log = jnp.log(jax.random.uniform(ks[12], (N_ODD, GDN_HEADS), f32, 1.0, 16.0))
    dt = jnp.exp(jax.random.uniform(ks[13], (N_ODD, GDN_HEADS), f32, math.log(1e-3), math.log(1e-1)))
    gdn_dt_bias = dt + jnp.log(-jnp.expm1(-dt))
    gdn_norm = gain(ks[14], (N_ODD, GDN_HEAD_DIM))
    gdn_w_out = dense(ks[15], (N_ODD, GDN_MIX_DIM, D_MODEL), GDN_MIX_DIM)
    ffn2_norm = gain(ks[16], (DEPTH, D_MODEL))
    ffn2_w_gate = dense(ks[17], (DEPTH, D_MODEL, D_FF), D_MODEL)
    ffn2_w_up = dense(ks[18], (DEPTH, D_MODEL, D_FF), D_MODEL)
    ffn2_w_down = dense(ks[19], (DEPTH, D_FF, D_MODEL), D_FF)
    final_norm = gain(ks[20], (D_MODEL,))
    return {'x': x, 'ffn1_norm': ffn1_norm, 'ffn1_w_gate': ffn1_w_gate, 'ffn1_w_up': ffn1_w_up,
            'ffn1_w_down': ffn1_w_down, 'mix_norm': mix_norm, 'att_w_in': att_w_in,
            'diff_lambda': diff_lambda, 'diff_subln': diff_subln, 'att_w_out': att_w_out,
            'gdn_w_in': gdn_w_in, 'gdn_conv_w': gdn_conv_w, 'gdn_a_log': gdn_a_log,
            'gdn_dt_bias': gdn_dt_bias, 'gdn_norm': gdn_norm, 'gdn_w_out': gdn_w_out,
            'ffn2_norm': ffn2_norm, 'ffn2_w_gate': ffn2_w_gate, 'ffn2_w_up': ffn2_w_up,
            'ffn2_w_down': ffn2_w_down, 'final_norm': final_norm}


def reference(x, ffn1_norm, ffn1_w_gate, ffn1_w_up, ffn1_w_down, mix_norm, att_w_in,
              diff_lambda, diff_subln, att_w_out, gdn_w_in, gdn_conv_w, gdn_a_log,
              gdn_dt_bias, gdn_norm, gdn_w_out, ffn2_norm, ffn2_w_gate, ffn2_w_up,
              ffn2_w_down, final_norm):
    for layer in range(DEPTH):
        x = x + 0.5 * swiglu(rms_norm(x, ffn1_norm[layer]), ffn1_w_gate[layer],
                             ffn1_w_up[layer], ffn1_w_down[layer])
        h = rms_norm(x, mix_norm[layer])
        if layer % 2 == 0:
            e = layer // 2
            x = x + even_mixer(h, att_w_in[e], diff_lambda[e], diff_subln[e], att_w_out[e], layer)
        else:
            o = layer // 2
            x = x + odd_mixer(h, gdn_w_in[o], gdn_conv_w[o], gdn_a_log[o], gdn_dt_bias[o],
                              gdn_norm[o], gdn_w_out[o])
        x = x + 0.5 * swiglu(rms_norm(x, ffn2_norm[layer]), ffn2_w_gate[layer],
                             ffn2_w_up[layer], ffn2_w_down[layer])
    return rms_norm(x, final_norm)
```

```cpp
#include <hip/hip_runtime.h>
#include <hip/hip_cooperative_groups.h>
#include <cstdio>
#include <cstdint>
namespace cg = cooperative_groups;
#ifndef PROBE
#define PROBE 0
#endif
#define REPS(bit) ((PROBE & (bit)) ? 2 : 1)
__device__ __forceinline__ int opaque_tid() { int t = (int)threadIdx.x; asm volatile("" : "+v"(t)); return t; }
namespace pg8 {
#define PG8_LAS __attribute__((address_space(3)))
typedef unsigned short bf16_t;
typedef short bf16x8 __attribute__((ext_vector_type(8)));
typedef float f32x4 __attribute__((ext_vector_type(4)));
typedef unsigned u32x4 __attribute__((ext_vector_type(4)));
constexpr int BM = 256, BK = 64, HALF = 128, HTB = HALF * BK * 2  , STAGE_BYTES = 8 * HTB, NXCD = 8, WGM = 8;

__host__ __device__ __forceinline__ int lds_byte(int r, int c) { const int st = (r >> 4) * 2 + (c >> 5), rr = r & 15, cc = c & 31, ob = rr * 64 + cc * 2; return st * 1024 + (ob ^ (((ob >> 9) & 1) << 5)); }
__host__ __device__ __forceinline__ void stage_rc(int b, int& R, int& C) { const int st = b / 1024, sb = b % 1024, swz = sb ^ (((sb >> 9) & 1) << 5); R = (st >> 1) * 16 + swz / 64; C = (st & 1) * 32 + (swz % 64) / 2; }
__host__ __device__ __forceinline__ int perm32(int rho) { const int n = rho >> 4, i = rho & 15; return 8 * (i >> 2) + 4 * n + (i & 3); }

struct Unit { int pm, pn; };
struct Gemm { const bf16_t* A; const bf16_t* Bt; int M, N, K; };

struct StaticOrder {
    int nM, nN, nwg, G, c;
    __host__ __device__ void init(int M, int N, int G_, int c_) { nM = M / BM; nN = N / BM; nwg = nM * nN; G = G_; c = c_; }
    __host__ __device__ bool next(int i, Unit& u) const {
        const long L = (long)i * G + c; if (L >= nwg) return false;
        int wgid = (int)L; { const int q = nwg / NXCD, r = nwg % NXCD, xcd = wgid % NXCD, off = wgid / NXCD; wgid = (xcd < r ? xcd * (q + 1) : r * (q + 1) + (xcd - r) * q) + off; }
        const int nig = WGM * nN, gid = wgid / nig, fm = gid * WGM, gsz = (nM - fm) < WGM ? (nM - fm) : WGM;
        u.pm = fm + ((wgid % nig) % gsz); u.pn = (wgid % nig) / gsz; return true;
    }
    __device__ __forceinline__ void a_ready(const Unit&) const {}
    __device__ __forceinline__ void done(const Unit&) const {}
};

template <class Epi, class Sched, bool ALIGN_EPI = false, bool SP2 = false>
__device__ __forceinline__ void gemm_phase(PG8_LAS unsigned char* lds, const Gemm g, const Sched& S, const Epi& E) {
    const int tid = opaque_tid(), wid = __builtin_amdgcn_readfirstlane(tid >> 6), lane = tid & 63, wr = wid >> 2, wc = wid & 3, fr = lane & 15, fq = lane >> 4;
    const int K = g.K, nt = K / BK;
    unsigned voffA[2], voffB[2];
#pragma unroll
    for (int i = 0; i < 2; ++i) { int R, C; stage_rc(tid * 16 + i * 8192, R, C); const int Rb = Epi::PERM ? ((R & ~31) + perm32(R & 31)) : R;
        voffA[i] = (unsigned)(R * K + C) * 2u; voffB[i] = (unsigned)(Rb * K + C) * 2u; }
    const size_t kstep = (size_t)(BK * 2);
    const size_t hstep = (size_t)HALF * K * 2;
    const size_t tstep = 2 * hstep;
    const unsigned ldsw = (unsigned)wid * 1024u;
    const int aoff = lds_byte(wr * 64 + fr, fq * 8), boff = lds_byte(wc * 32 + fr, fq * 8);
#define PG8_SA(b, h) (((b) * 2 + (h)) * HTB)
#define PG8_SB(b, h) ((4 + (b) * 2 + (h)) * HTB)
#define PG8_STAGE(bufoff, gbase, voff) do { _Pragma("unroll") for (int _i = 0; _i < 2; ++_i) \
        __builtin_amdgcn_global_load_lds((const unsigned*)((const char*)(gbase) + (voff)[_i]), (PG8_LAS unsigned*)(lds + (bufoff) + ldsw + _i * 8192), 16, 0, 0); } while (0)
#define PG8_LDA(dst, b, h) do { _Pragma("unroll") for (int m = 0; m < 4; ++m) _Pragma("unroll") for (int k = 0; k < 2; ++k) dst[m][k] = *(const PG8_LAS bf16x8*)(lds + PG8_SA(b, h) + aoff + m * 2048 + k * 1024); } while (0)
#define PG8_LDB(dst, b, h) do { _Pragma("unroll") for (int n = 0; n < 2; ++n) _Pragma("unroll") for (int k = 0; k < 2; ++k) dst[n][k] = *(const PG8_LAS bf16x8*)(lds + PG8_SB(b, h) + boff + n * 2048 + k * 1024); } while (0)
#define PG8_MMA(ai, bj, At, Bt) do { __builtin_amdgcn_s_setprio(1); _Pragma("unroll") for (int m = 0; m < 4; ++m) _Pragma("unroll") for (int n = 0; n < 2; ++n) _Pragma("unroll") for (int k = 0; k < 2; ++k) \
        acc[ai][bj][m][n] = __builtin_amdgcn_mfma_f32_16x16x32_bf16(Bt[n][k], At[m][k], acc[ai][bj][m][n], 0, 0, 0); __builtin_amdgcn_s_setprio(0); } while (0)
#define PG8_WAIT_V(n) asm volatile("s_waitcnt vmcnt(" #n ")" ::: "memory")
#define PG8_WAIT_L(n) asm volatile("s_waitcnt lgkmcnt(" #n ")" ::: "memory")
#define PG8_BAR __builtin_amdgcn_s_barrier()
#define PG8_SCHED __builtin_amdgcn_sched_barrier(0)
    Unit cur, nxt; int ui = 0;
    if (!S.next(0, cur)) return;
    f32x4 acc[2][2][4][2];
#pragma unroll
    for (int a = 0; a < 2; ++a)
#pragma unroll
        for (int b = 0; b < 2; ++b)
#pragma unroll
            for (int m = 0; m < 4; ++m)
#pragma unroll
                for (int n = 0; n < 2; ++n) acc[a][b][m][n] = (f32x4){0.f, 0.f, 0.f, 0.f};
    bf16x8 At[4][2], B0[2][2], B1[2][2];
    const char* cA = (const char*)g.A + (size_t)cur.pm * tstep; const char* cB = (const char*)g.Bt + (size_t)cur.pn * tstep;
    S.a_ready(cur);
    if constexpr (SP2) {
        PG8_STAGE(PG8_SB(0, 0), cB, voffB); PG8_STAGE(PG8_SB(0, 1), cB + hstep, voffB); PG8_STAGE(PG8_SA(0, 0), cA, voffA); PG8_STAGE(PG8_SA(0, 1), cA + hstep, voffA);
        if (wr == 1) PG8_BAR;
        PG8_WAIT_V(2); PG8_BAR;
        PG8_STAGE(PG8_SB(1, 0), cB + kstep, voffB); PG8_STAGE(PG8_SA(1, 0), cA + kstep, voffA); PG8_STAGE(PG8_SB(1, 1), cB + hstep + kstep, voffB);
        PG8_WAIT_V(6); PG8_BAR;
    } else {
        PG8_STAGE(PG8_SB(0, 0), cB, voffB); PG8_STAGE(PG8_SA(0, 0), cA, voffA); PG8_STAGE(PG8_SB(0, 1), cB + hstep, voffB); PG8_STAGE(PG8_SA(0, 1), cA + hstep, voffA);
        if (wr == 1) PG8_BAR;
        PG8_WAIT_V(4); PG8_BAR;
        PG8_STAGE(PG8_SB(1, 0), cB + kstep, voffB); PG8_STAGE(PG8_SA(1, 0), cA + kstep, voffA); PG8_STAGE(PG8_SB(1, 1), cB + hstep + kstep, voffB);
        PG8_WAIT_V(6); PG8_BAR;
    }
    for (;;) {
        const bool has_next = S.next(ui + 1, nxt);
        const char* nA = has_next ? (const char*)g.A + (size_t)nxt.pm * tstep : cA; const char* nB = has_next ? (const char*)g.Bt + (size_t)nxt.pn * tstep : cB;
        for (int t = 0; t < nt; t += 2) {
            const bool last = (t == nt - 2);
            const char* a1 = cA + (size_t)(t + 1) * kstep;
            const char* a2 = last ? nA : cA + (size_t)(t + 2) * kstep; const char* b2 = last ? nB : cB + (size_t)(t + 2) * kstep;
            const char* a3 = a2 + kstep; const char* b3 = b2 + kstep;
            if (last && has_next) S.a_ready(nxt);
            if constexpr (SP2) {
            PG8_LDB(B0, 0, 0); PG8_LDB(B1, 0, 1); PG8_SCHED; PG8_LDA(At, 0, 0); PG8_STAGE(PG8_SA(1, 1), a1 + hstep, voffA);
            PG8_WAIT_V(8); PG8_WAIT_L(0); PG8_BAR; PG8_MMA(0, 0, At, B0); PG8_MMA(0, 1, At, B1); PG8_BAR; PG8_SCHED;
            PG8_LDA(At, 0, 1); PG8_STAGE(PG8_SB(0, 0), b2, voffB); PG8_STAGE(PG8_SB(0, 1), b2 + hstep, voffB); PG8_STAGE(PG8_SA(0, 0), a2, voffA);
            PG8_WAIT_V(8); PG8_WAIT_L(0); PG8_BAR; PG8_MMA(1, 0, At, B0); PG8_MMA(1, 1, At, B1); PG8_BAR; PG8_SCHED;
            PG8_LDB(B0, 1, 0); PG8_LDB(B1, 1, 1); PG8_SCHED; PG8_LDA(At, 1, 0); PG8_STAGE(PG8_SA(0, 1), a2 + hstep, voffA);
            PG8_WAIT_V(8); PG8_WAIT_L(0); PG8_BAR; PG8_MMA(0, 0, At, B0); PG8_MMA(0, 1, At, B1); PG8_BAR; PG8_SCHED;
            PG8_LDA(At, 1, 1); PG8_STAGE(PG8_SB(1, 0), b3, voffB); PG8_STAGE(PG8_SB(1, 1), b3 + hstep, voffB); PG8_STAGE(PG8_SA(1, 0), a3, voffA);
            PG8_WAIT_V(8); PG8_WAIT_L(0); PG8_BAR; PG8_MMA(1, 0, At, B0); PG8_MMA(1, 1, At, B1); PG8_BAR; PG8_SCHED;
            } else {
            PG8_LDB(B0, 0, 0); PG8_SCHED; PG8_LDA(At, 0, 0); PG8_STAGE(PG8_SA(1, 1), a1 + hstep, voffA);
            PG8_WAIT_L(8); PG8_BAR; PG8_WAIT_L(0); PG8_MMA(0, 0, At, B0); PG8_BAR; PG8_SCHED;
            PG8_LDB(B1, 0, 1); PG8_STAGE(PG8_SB(0, 0), b2, voffB);
            PG8_BAR; PG8_WAIT_L(0); PG8_MMA(0, 1, At, B1); PG8_BAR;
            PG8_LDA(At, 0, 1); PG8_STAGE(PG8_SA(0, 0), a2, voffA);
            PG8_BAR; PG8_WAIT_L(0); PG8_MMA(1, 0, At, B0); PG8_BAR; PG8_SCHED;
            PG8_STAGE(PG8_SB(0, 1), b2 + hstep, voffB);
            PG8_WAIT_V(6); PG8_BAR; PG8_MMA(1, 1, At, B1); PG8_BAR;
            PG8_LDB(B0, 1, 0); PG8_SCHED; PG8_LDA(At, 1, 0); PG8_STAGE(PG8_SA(0, 1), a2 + hstep, voffA);
            PG8_WAIT_L(8); PG8_BAR; PG8_WAIT_L(0); PG8_MMA(0, 0, At, B0); PG8_BAR; PG8_SCHED;
            PG8_LDB(B1, 1, 1); PG8_STAGE(PG8_SB(1, 0), b3, voffB);
            PG8_BAR; PG8_WAIT_L(0); PG8_MMA(0, 1, At, B1); PG8_BAR;
            PG8_LDA(At, 1, 1); PG8_STAGE(PG8_SA(1, 0), a3, voffA);
            PG8_BAR; PG8_WAIT_L(0); PG8_MMA(1, 0, At, B0); PG8_BAR; PG8_SCHED;
            PG8_STAGE(PG8_SB(1, 1), b3 + hstep, voffB);
            PG8_WAIT_V(6); PG8_BAR; PG8_MMA(1, 1, At, B1); PG8_BAR;
            }
        }
        if constexpr (ALIGN_EPI) { if (wr == 0) PG8_BAR; }
        if constexpr (!Epi::AFTER_DRAIN) { E(acc, cur, wr, wc, fr, fq); S.done(cur); }
        if (!has_next) break;
#pragma unroll
        for (int a = 0; a < 2; ++a)
#pragma unroll
            for (int b = 0; b < 2; ++b)
#pragma unroll
                for (int m = 0; m < 4; ++m)
#pragma unroll
                    for (int n = 0; n < 2; ++n) acc[a][b][m][n] = (f32x4){0.f, 0.f, 0.f, 0.f};
        cur = nxt; cA = nA; cB = nB; ++ui;
        if constexpr (ALIGN_EPI) { if (wr == 1) PG8_BAR; }
    }
    PG8_WAIT_V(0);
    if constexpr (!ALIGN_EPI) { if (wr == 0) PG8_BAR; }
    PG8_BAR;
    if constexpr (Epi::AFTER_DRAIN) { E.fused(acc, cur, wr, wc, fr, fq, lds, wid, lane); S.done(cur); }
#undef PG8_SA
#undef PG8_SB
#undef PG8_STAGE
#undef PG8_LDA
#undef PG8_LDB
#undef PG8_MMA
#undef PG8_WAIT_V
#undef PG8_WAIT_L
#undef PG8_BAR
#undef PG8_SCHED
}
}

#define LAS __attribute__((address_space(3)))
typedef unsigned short bf16_t;
typedef short bf16x8 __attribute__((ext_vector_type(8)));
typedef short s16x4 __attribute__((ext_vector_type(4)));
typedef float f32x4 __attribute__((ext_vector_type(4)));
typedef float f32x16 __attribute__((ext_vector_type(16)));
typedef unsigned u32x4 __attribute__((ext_vector_type(4)));
typedef unsigned u32x2 __attribute__((ext_vector_type(2)));
typedef float f32x2_t __attribute__((ext_vector_type(2)));
typedef __bf16 bf16x2_t __attribute__((ext_vector_type(2)));
typedef LAS unsigned char* lptr;
#define BAR_LDS() asm volatile("s_waitcnt lgkmcnt(0)\n\ts_barrier" ::: "memory")
#define MFMA32(a, b, c) __builtin_amdgcn_mfma_f32_32x32x16_bf16((a), (b), (c), 0, 0, 0)

constexpr int BATCH = 4, SEQ = 4096, DM = 1024, DFF = 2816, M = BATCH * SEQ;
constexpr float RMS_EPS = 1e-6f, LOG2E = 1.4426950408889634f;
constexpr size_t MiB = 1u << 20;
constexpr size_t WS_WGU1 = 0, WS_WD1 = 11534336, WS_WIN = 17301504, WS_WOUT = 25690112, WS_WGU2 = 27787264, WS_WD2 = 39321600;
constexpr size_t WS_H = 48 * MiB, WS_AB = 80 * MiB, WS_CD = 81 * MiB, WS_BAR = 81 * MiB + 512 * 1024, WS_R1 = 82 * MiB, WS_R2 = 210 * MiB;
constexpr size_t WS_HID = WS_R2, WS_WG = WS_R2, WS_QD = WS_R2 + 32 * MiB, WS_KDT = WS_R2 + 64 * MiB, WS_AQK = WS_R2 + 96 * MiB, WS_U = WS_R2 + 112 * MiB, WS_END = WS_R2 + 176 * MiB;
constexpr size_t WS_XB = WS_R2 + 96 * MiB;
constexpr size_t WS_SS = 44 * MiB;
constexpr int LDS_BYTES = 147456;

__device__ __forceinline__ unsigned pk2(float lo, float hi) { f32x2_t v = {lo, hi}; bf16x2_t b = __builtin_convertvector(v, bf16x2_t); return __builtin_bit_cast(unsigned, b); }
__device__ __forceinline__ float bf_lo(unsigned u) { return __uint_as_float(u << 16); }
__device__ __forceinline__ float bf_hi(unsigned u) { return __uint_as_float(u & 0xffff0000u); }
template <int CTRL> __device__ __forceinline__ float dpp_f(float v) { return __uint_as_float((unsigned)__builtin_amdgcn_update_dpp(0, (int)__float_as_uint(v), CTRL, 0xf, 0xf, false)); }
__device__ __forceinline__ float row16_sum(float v) { v += dpp_f<0x128>(v); v += dpp_f<0x124>(v); v += dpp_f<0x122>(v); v += dpp_f<0x121>(v); return v; }
__device__ __forceinline__ float x16_sum(float v) { auto rr = __builtin_amdgcn_permlane16_swap(__float_as_uint(v), __float_as_uint(v), false, false); return __uint_as_float(rr[0]) + __uint_as_float(rr[1]); }
__device__ __forceinline__ float x32_sum(float v) { auto rr = __builtin_amdgcn_permlane32_swap(__float_as_uint(v), __float_as_uint(v), false, false); return __uint_as_float(rr[0]) + __uint_as_float(rr[1]); }
__device__ __forceinline__ float x32_max(float v) { auto rr = __builtin_amdgcn_permlane32_swap(__float_as_uint(v), __float_as_uint(v), false, false); return fmaxf(__uint_as_float(rr[0]), __uint_as_float(rr[1])); }
__device__ __forceinline__ float x32_other(float v, int hi) { auto rr = __builtin_amdgcn_permlane32_swap(__float_as_uint(v), __float_as_uint(v), false, false); return __uint_as_float(hi ? rr[0] : rr[1]); }
__device__ __forceinline__ float wave_sum(float v) { return x32_sum(x16_sum(row16_sum(v))); }
__device__ __forceinline__ int crow(int r, int hi) { return (r & 3) + 8 * (r >> 2) + 4 * hi; }
__device__ __forceinline__ float fast_exp2(float x) { return __builtin_amdgcn_exp2f(x); }
__device__ __forceinline__ float fast_log2(float x) { return __builtin_amdgcn_logf(x); }
__device__ __forceinline__ float fexp(float x) { return __builtin_amdgcn_exp2f(x * LOG2E); }
__device__ __forceinline__ float silu_f(float g) { return g * __builtin_amdgcn_rcpf(1.0f + __expf(-g)); }

__device__ __forceinline__ float row_rstd(const float* ss, int row) {
    const f32x4* q = (const f32x4*)(ss + (size_t)row * 16); const f32x4 a = q[0], b = q[1], c = q[2], d = q[3];
    const float t = ((a[0] + a[1]) + (a[2] + a[3])) + ((b[0] + b[1]) + (b[2] + b[3])) + ((c[0] + c[1]) + (c[2] + c[3])) + ((d[0] + d[1]) + (d[2] + d[3]));
    return rsqrtf(t * (1.f / DM) + RMS_EPS);
}
extern __shared__ __attribute__((aligned(16))) unsigned char lds_raw[];
constexpr int RS_TAB_OFF = 132096, RS_PM_OFF = 136192;
__device__ __forceinline__ const LAS float* rstd_table(const float* ss, int pm, int wr, int wc, int lane) {
    const lptr l0 = (lptr)lds_raw;
    const int wave = wr * 4 + wc;
    LAS float* tab = (LAS float*)(l0 + RS_TAB_OFF + wave * 512);
    LAS int* cpm = (LAS int*)(l0 + RS_PM_OFF + wave * 4);
    if (cpm[0] != pm) {
        tab[lane] = row_rstd(ss, pm * 256 + wr * 64 + lane);
        tab[64 + lane] = row_rstd(ss, pm * 256 + 128 + wr * 64 + lane);
        if (lane == 0) cpm[0] = pm;
        asm volatile("s_waitcnt lgkmcnt(0)" ::: "memory");
    }
    return tab;
}
struct EpiSwiGLU {
    static constexpr bool PERM = true, AFTER_DRAIN = false;
    bf16_t* O; int ldc; const float* ss;
    __device__ __forceinline__ void operator()(const pg8::f32x4 (&acc)[2][2][4][2], const pg8::Unit& u, int wr, int wc, int fr, int fq) const {
        const int row0 = u.pm * 256 + wr * 64 + fr, col0 = u.pn * 128 + wc * 32 + 8 * fq;
        const LAS float* tab = rstd_table(ss, u.pm, wr, wc, fr + 16 * fq);
#pragma unroll
        for (int ai = 0; ai < 2; ++ai)
#pragma unroll
            for (int m = 0; m < 4; ++m) {
                const int row = row0 + ai * 128 + m * 16;
                const float rs = tab[64 * ai + 16 * m + fr];
                bf16_t* rowp = O + (size_t)row * ldc + col0;
                const pg8::f32x4 g0 = acc[ai][0][m][0] * rs, g1 = acc[ai][0][m][1] * rs, u0 = acc[ai][1][m][0] * rs, u1 = acc[ai][1][m][1] * rs;
                u32x4 w;
                w.x = pk2(silu_f(g0[0]) * u0[0], silu_f(g0[1]) * u0[1]); w.y = pk2(silu_f(g0[2]) * u0[2], silu_f(g0[3]) * u0[3]);
                w.z = pk2(silu_f(g1[0]) * u1[0], silu_f(g1[1]) * u1[1]); w.w = pk2(silu_f(g1[2]) * u1[2], silu_f(g1[3]) * u1[3]);
                *(u32x4*)rowp = w;
            }
    }
};
template <bool HALF> struct EpiResid {
    static constexpr bool PERM = true, AFTER_DRAIN = false;
    static constexpr float s = HALF ? 0.5f : 1.0f;
    bf16_t* xb; float* ssn;
    __device__ __forceinline__ void operator()(const pg8::f32x4 (&acc)[2][2][4][2], const pg8::Unit& u, int wr, int wc, int fr, int fq) const {
        const int row0 = u.pm * 256 + wr * 64 + fr, col0 = u.pn * 256 + wc * 32 + 8 * fq;
#pragma unroll
        for (int ai = 0; ai < 2; ++ai)
#pragma unroll
            for (int m = 0; m < 4; ++m) {
                const int row = row0 + ai * 128 + m * 16;
                bf16_t* rowp = xb + (size_t)row * DM + col0;
                float q = 0.f;
#pragma unroll
                for (int bj = 0; bj < 2; ++bj) {
                    const u32x4 bb = *(const u32x4*)(rowp + bj * 128);
                    const pg8::f32x4 b0 = {bf_lo(bb.x), bf_hi(bb.x), bf_lo(bb.y), bf_hi(bb.y)}, b1 = {bf_lo(bb.z), bf_hi(bb.z), bf_lo(bb.w), bf_hi(bb.w)};
                    const pg8::f32x4 v0 = b0 + acc[ai][bj][m][0] * s, v1 = b1 + acc[ai][bj][m][1] * s;
                    u32x4 w; w.x = pk2(v0[0], v0[1]); w.y = pk2(v0[2], v0[3]); w.z = pk2(v1[0], v1[1]); w.w = pk2(v1[2], v1[3]);
                    *(u32x4*)(rowp + bj * 128) = w;
                    q += ((v0[0] * v0[0] + v0[1] * v0[1]) + (v0[2] * v0[2] + v0[3] * v0[3])) + ((v1[0] * v1[0] + v1[1] * v1[1]) + (v1[2] * v1[2] + v1[3] * v1[3]));
                }
                q = x32_sum(x16_sum(q));
                if (fq == 0) ssn[(size_t)row * 16 + u.pn * 4 + wc] = q;
            }
    }
};
struct EpiBf16 {
    static constexpr bool PERM = true, AFTER_DRAIN = false;
    bf16_t* O; int ldc; const float* ss;
    __device__ __forceinline__ void operator()(const pg8::f32x4 (&acc)[2][2][4][2], const pg8::Unit& u, int wr, int wc, int fr, int fq) const {
        const int row0 = u.pm * 256 + wr * 64 + fr, col0 = u.pn * 256 + wc * 32 + 8 * fq;
        const LAS float* tab = rstd_table(ss, u.pm, wr, wc, fr + 16 * fq);
#pragma unroll
        for (int ai = 0; ai < 2; ++ai)
#pragma unroll
            for (int m = 0; m < 4; ++m) {
                const int row = row0 + ai * 128 + m * 16;
                const float rs = tab[64 * ai + 16 * m + fr];
                bf16_t* rowp = O + (size_t)row * ldc + col0;
#pragma unroll
                for (int bj = 0; bj < 2; ++bj) {
                    const pg8::f32x4 v0 = acc[ai][bj][m][0] * rs, v1 = acc[ai][bj][m][1] * rs;
                    u32x4 w; w.x = pk2(v0[0], v0[1]); w.y = pk2(v0[2], v0[3]); w.z = pk2(v1[0], v1[1]); w.w = pk2(v1[2], v1[3]);
                    *(u32x4*)(rowp + bj * 128) = w;
                }
            }
    }
};
template <class Epi>
__device__ __forceinline__ void run_gemm(lptr lds, const bf16_t* A, const bf16_t* Bt, int N, int K, const Epi& E) {
    { const int t_ = opaque_tid(); if ((t_ & 63) == 0) *(LAS int*)(lds + RS_PM_OFF + (t_ >> 6) * 4) = -1; }
    pg8::Gemm g{A, Bt, M, N, K}; pg8::StaticOrder S; S.init(M, N, (int)gridDim.x, (int)blockIdx.x);
    pg8::gemm_phase<Epi, pg8::StaticOrder, true, true>(lds, g, S, E);
}

__device__ __forceinline__ void tr_item(const float* W, int ldw, int k0, int n0, bf16_t* WT, int K, int drow0, LAS float* scr, int lane, const float* nw) {
    float tv[32];
#pragma unroll
    for (int i = 0; i < 32; ++i) tv[i] = W[(size_t)(k0 + 2 * i + (lane >> 5)) * ldw + n0 + (lane & 31)];
#pragma unroll
    for (int i = 0; i < 32; ++i) scr[(2 * i + (lane >> 5)) * 33 + (lane & 31)] = nw ? tv[i] * nw[k0 + 2 * i + (lane >> 5)] : tv[i];
    asm volatile("s_waitcnt lgkmcnt(0)" ::: "memory");
    const int c = lane & 7;
#pragma unroll
    for (int j = 0; j < 4; ++j) {
        const int n = (lane >> 3) + 8 * j; const LAS float* s = scr + (8 * c) * 33 + n;
        u32x4 o; o.x = pk2(s[0 * 33], s[1 * 33]); o.y = pk2(s[2 * 33], s[3 * 33]); o.z = pk2(s[4 * 33], s[5 * 33]); o.w = pk2(s[6 * 33], s[7 * 33]);
        *(u32x4*)(WT + (size_t)(drow0 + n) * K + k0 + 8 * c) = o;
    }
    asm volatile("s_waitcnt lgkmcnt(0)" ::: "memory");
}
struct Params { const float* in[21]; float* out; unsigned char* ws; };

__device__ __forceinline__ void convert_layer(const Params& p, int l, lptr lds, int part, int b0) {
    const int tid = opaque_tid(), lane = tid & 63, wave = tid >> 6;
    LAS float* scr = (LAS float*)(lds + wave * 16384);
    const int gw = ((int)blockIdx.x - b0) * 8 + wave, NGW = ((int)gridDim.x - b0) * 8;
    const bool odd = l & 1; const int e = l >> 1;
    const float* Win = odd ? p.in[10] + (size_t)e * DM * 4112 : p.in[6] + (size_t)e * DM * 3072;
    const int ldin = odd ? 4112 : 3072, nin = odd ? 4096 : 3072;
    const float* Wout = odd ? p.in[15] + (size_t)e * DM * DM : p.in[9] + (size_t)e * DM * DM;
    const int I_G = (DM / 64) * (DFF / 32), I_D = (DFF / 64) * (DM / 32), I_IN = (DM / 64) * (nin / 32), I_OUT = (DM / 64) * (DM / 32);
    const int n1 = 2 * I_G + I_D, total = 4 * I_G + 2 * I_D + I_IN + I_OUT;
    for (int it = (part == 1 ? 0 : n1) + gw; it < (part == 1 ? n1 : total); it += NGW) {
        int r = it;
#define SEG(Wp, LDW, KK, NITEMS, NBLK, WTOFF, MODE, NW) \
        if (r < (NITEMS)) { const int kb = r / (NBLK), nb = r % (NBLK); const int n0 = 32 * nb; \
            const int dr = (MODE) == 0 ? n0 : ((n0 >> 7) * 256 + (n0 & 127) + ((MODE) == 2 ? 128 : 0)); \
            tr_item((Wp), (LDW), 64 * kb, n0, (bf16_t*)(p.ws + (WTOFF)), (KK), dr, scr, lane, (NW)); continue; } r -= (NITEMS);
        SEG(p.in[2] + (size_t)l * DM * DFF, DFF, DM, I_G, DFF / 32, WS_WGU1, 1, p.in[1] + (size_t)l * DM)
        SEG(p.in[3] + (size_t)l * DM * DFF, DFF, DM, I_G, DFF / 32, WS_WGU1, 2, p.in[1] + (size_t)l * DM)
        SEG(p.in[4] + (size_t)l * DM * DFF, DM, DFF, I_D, DM / 32, WS_WD1, 0, (const float*)nullptr)
        if (odd) { SEG(Win, 4112, DM, 2048, 128, WS_WIN, 0, p.in[5] + (size_t)l * DM) } else { SEG(Win, 3072, DM, 1536, 96, WS_WIN, 0, p.in[5] + (size_t)l * DM) }
        SEG(Wout, DM, DM, I_OUT, DM / 32, WS_WOUT, 0, (const float*)nullptr)
        SEG(p.in[17] + (size_t)l * DM * DFF, DFF, DM, I_G, DFF / 32, WS_WGU2, 1, p.in[16] + (size_t)l * DM)
        SEG(p.in[18] + (size_t)l * DM * DFF, DFF, DM, I_G, DFF / 32, WS_WGU2, 2, p.in[16] + (size_t)l * DM)
        SEG(p.in[19] + (size_t)l * DM * DFF, DM, DFF, I_D, DM / 32, WS_WD2, 0, (const float*)nullptr)
#undef SEG
    }
}

__device__ __forceinline__ void prologue_phase(const float* X, bf16_t* XB, float* ss) {
    const int tid = opaque_tid(), lane = tid & 63, wave = tid >> 6;
    const int gw = blockIdx.x * 8 + wave, NGW = gridDim.x * 8;
    for (int m = gw; m < M; m += NGW) {
        const f32x4* xr = (const f32x4*)(X + (size_t)m * DM) + lane;
        f32x4 v[4]; float s = 0.f;
#pragma unroll
        for (int j = 0; j < 4; ++j) { v[j] = xr[64 * j]; s += (v[j][0] * v[j][0] + v[j][1] * v[j][1]) + (v[j][2] * v[j][2] + v[j][3] * v[j][3]); }
        s = wave_sum(s);
        u32x2* o8 = (u32x2*)(XB + (size_t)m * DM) + lane;
#pragma unroll
        for (int j = 0; j < 4; ++j) { u32x2 o; o.x = pk2(v[j][0], v[j][1]); o.y = pk2(v[j][2], v[j][3]); o8[64 * j] = o; }
        if (lane < 16) ss[(size_t)m * 16 + lane] = lane == 0 ? s : 0.f;
    }
}
__device__ __forceinline__ void ab_phase(const bf16_t* XBp, const float* w, const float* ss, const float* W16src, float* ABout, lptr lds) {
    const int tid = opaque_tid(), lane = tid & 63, wave = tid >> 6;
    const int gw = blockIdx.x * 8 + wave, NGW = gridDim.x * 8;
    LAS float* W16t = (LAS float*)lds;
    for (int k = tid; k < DM; k += 512) {
        const f32x4* src = (const f32x4*)(W16src + (size_t)k * 4112);
#pragma unroll
        for (int q = 0; q < 4; ++q) { const f32x4 v = src[q]; W16t[(4 * q + 0) * 1024 + k] = v[0]; W16t[(4 * q + 1) * 1024 + k] = v[1]; W16t[(4 * q + 2) * 1024 + k] = v[2]; W16t[(4 * q + 3) * 1024 + k] = v[3]; }
    }
    __syncthreads();
    f32x4 wv[4];
#pragma unroll
    for (int j = 0; j < 4; ++j) wv[j] = ((const f32x4*)w)[64 * j + lane];
    for (int m = gw; m < M; m += NGW) {
        const u32x2* xr = (const u32x2*)(XBp + (size_t)m * DM) + lane;
        const float rstd = row_rstd(ss, m);
        f32x4 v[4];
#pragma unroll
        for (int j = 0; j < 4; ++j) { const u32x2 t = xr[64 * j]; const f32x4 xv = {bf_lo(t.x), bf_hi(t.x), bf_lo(t.y), bf_hi(t.y)}; v[j] = xv * rstd * wv[j]; }
        float mine = 0.f;
#pragma nounroll
        for (int c = 0; c < 16; ++c) {
            float a = 0.f;
#pragma unroll
            for (int j = 0; j < 4; ++j) { const f32x4 t = *(const LAS f32x4*)(W16t + c * 1024 + 256 * j + 4 * lane); a += (v[j][0] * t[0] + v[j][1] * t[1]) + (v[j][2] * t[2] + v[j][3] * t[3]); }
            a = wave_sum(a);
            if (lane == c) mine = a;
        }
        if (lane < 16) ABout[(size_t)m * 16 + lane] = mine;
    }
    __syncthreads();
}
__device__ __forceinline__ void final_norm_phase(const bf16_t* XBp, float* out, const float* w) {
    const int tid = opaque_tid(), lane = tid & 63, wave = tid >> 6;
    const int gw = blockIdx.x * 8 + wave, NGW = gridDim.x * 8;
    f32x4 wv[4];
#pragma unroll
    for (int j = 0; j < 4; ++j) wv[j] = ((const f32x4*)w)[64 * j + lane];
    for (int m = gw; m < M; m += NGW) {
        const u32x2* xr = (const u32x2*)(XBp + (size_t)m * DM) + lane;
        f32x4* orow = (f32x4*)(out + (size_t)m * DM) + lane;
        f32x4 v[4]; float s = 0.f;
#pragma unroll
        for (int j = 0; j < 4; ++j) { const u32x2 t = xr[64 * j]; v[j] = (f32x4){bf_lo(t.x), bf_hi(t.x), bf_lo(t.y), bf_hi(t.y)}; s += (v[j][0] * v[j][0] + v[j][1] * v[j][1]) + (v[j][2] * v[j][2] + v[j][3] * v[j][3]); }
        const float rstd = rsqrtf(wave_sum(s) * (1.f / DM) + RMS_EPS);
#pragma unroll
        for (int j = 0; j < 4; ++j) orow[64 * j] = v[j] * rstd * wv[j];
    }
}

namespace att {
constexpr int PLD = 3072, KROWB = 272, VROWB = 136;
constexpr int SLOT = 64 * KROWB + 128 * VROWB;
constexpr int OFF_STAT = 2 * SLOT, OFF_X = OFF_STAT + 256;

template <int MODE>
__device__ __forceinline__ void unit(const bf16_t* P, bf16_t* AO, int b, int h, int qb, lptr sm, float lam, const float* subln, float lam_init) {
    const int tid = opaque_tid(), lane = tid & 63, wid = __builtin_amdgcn_readfirstlane(tid >> 6), r32 = lane & 31, hi = lane >> 5;
    constexpr int UROWS = MODE ? 256 : 128;
    const int comp = MODE ? 0 : (wid >> 2);
    const int q0 = qb * UROWS, tq0 = q0 + 32 * (MODE ? wid : (wid & 3)), tq = tq0 + r32;
    const size_t rowbase = (size_t)b * SEQ;
    const int qcol = MODE ? 1536 + h * 128 : h * 128 + 64 * comp;
    const int kcol = MODE ? 2048 + h * 128 : 512 + h * 128;
    const int vcol = MODE ? 2560 + h * 128 : 1024 + h * 128;
    constexpr int NJ = MODE ? 8 : 4;
    bf16x8 qf[NJ];
#pragma unroll
    for (int j = 0; j < NJ; ++j) qf[j] = *(const bf16x8*)(P + (rowbase + tq) * PLD + qcol + 16 * j + 8 * hi);
    const int nt = (q0 + UROWS) / 64;
    const int kt_d = tq0 >> 6, dsub = (tq0 >> 5) & 1;
    const int krow0 = tid >> 4, kseg = tid & 15;
    const int vo = 4 * (wid & 3) + (lane & 3), vp = 16 * (wid >> 2) + (lane >> 2);
    u32x4 kA0, kA1, vA0, vA1, kB0, kB1, vB0, vB1;
#define ATT_LOAD(kt, K0, K1, V0, V1) do { const bf16_t* kb_ = P + (rowbase + (size_t)(kt) * 64) * PLD; \
        K0 = *(const u32x4*)(kb_ + (size_t)krow0 * PLD + kcol + kseg * 8); K1 = *(const u32x4*)(kb_ + (size_t)(krow0 + 32) * PLD + kcol + kseg * 8); \
        V0 = *(const u32x4*)(kb_ + (size_t)(2 * vp) * PLD + vcol + 8 * vo); V1 = *(const u32x4*)(kb_ + (size_t)(2 * vp + 1) * PLD + vcol + 8 * vo); } while (0)
#define ATT_STORE(slot, K0, K1, V0, V1) do { const lptr sb_ = sm + (slot) * SLOT; \
        *(LAS u32x4*)(sb_ + krow0 * KROWB + kseg * 16) = K0; *(LAS u32x4*)(sb_ + (krow0 + 32) * KROWB + kseg * 16) = K1; \
        _Pragma("unroll") for (int i = 0; i < 8; ++i) { \
            const unsigned w_ = __builtin_amdgcn_perm(V1[i >> 1], V0[i >> 1], (i & 1) ? 0x07060302u : 0x05040100u);     \
            *(LAS unsigned*)(sb_ + 64 * KROWB + (8 * vo + i) * VROWB + 4 * vp) = w_; } } while (0)
    LAS int* stat = (LAS int*)(sm + OFF_STAT);
    __syncthreads();
    if (tid < 16) stat[tid] = 0;
    if (MODE == 0) {
        ATT_LOAD(nt - 1, kB0, kB1, vB0, vB1);
        ATT_STORE(1, kB0, kB1, vB0, vB1);
        ATT_LOAD(nt - 2, kA0, kA1, vA0, vA1);
        ATT_LOAD(nt >= 4 ? nt - 3 : 0, kB0, kB1, vB0, vB1);
    } else {
        ATT_LOAD(nt - 1, kA0, kA1, vA0, vA1);
        ATT_STORE(1, kA0, kA1, vA0, vA1);
        ATT_LOAD(nt - 2, kA0, kA1, vA0, vA1);
    }
    f32x16 O[4];
#pragma unroll
    for (int i = 0; i < 4; ++i)
#pragma unroll
        for (int r = 0; r < 16; ++r) O[i][r] = 0.f;
    float mrun = -1e30f, lrun = 0.f, Crun = 0.f;
    bool wdone = false;
    const float slope2 = fast_exp2(-2.0f * (float)(h + 1)) * LOG2E;
    const float c1 = (MODE ? 0.08838834764831845f : 0.125f) * LOG2E;
    const float slc = slope2 / c1;
    if (wid >= 4) __builtin_amdgcn_s_setprio(1);
    bool stop = false;
#define ATT_HEAD(kt, K0, K1, V0, V1) \
        BAR_LDS();                            \
        int doneall = 0; \
        if (MODE) { const LAS int* st = stat + 8 * (((kt) + 1) & 1); doneall = (st[0] + st[1]) + (st[2] + st[3]) + (st[4] + st[5]) + (st[6] + st[7]); } \
        if (MODE == 0) { ATT_STORE(((kt) - 1) & 1, K0, K1, V0, V1); ATT_LOAD((kt) > 3 ? (kt) - 3 : 0, K0, K1, V0, V1); }     \
        else if ((kt) > 0) { ATT_STORE(((kt) - 1) & 1, K0, K1, V0, V1); if ((kt) > 1) ATT_LOAD((kt) - 2, K0, K1, V0, V1); }
    for (int kt2 = nt - 1; kt2 >= 0 && !stop; kt2 -= 2)
#pragma unroll
    for (int half = 0; half < 2; ++half) {
        const int kt = kt2 - half;
        if (stop) continue;
        int doneall_;
        if (half == 0 || MODE == 1) { ATT_HEAD(kt, kA0, kA1, vA0, vA1) doneall_ = doneall; }
        else { ATT_HEAD(kt, kB0, kB1, vB0, vB1) doneall_ = doneall; }
        const int doneall = doneall_;
        if (MODE && doneall == 8) { stop = true; continue; }
        const lptr Ks = sm + (kt & 1) * SLOT, Vs = Ks + 64 * KROWB;
        if (kt <= kt_d && !wdone) {
        if (MODE == 0) {
            f32x16 s[2];
            const bool diag = (kt == kt_d);
            const float bias0 = diag ? 0.f : slc * (float)(kt * 64 + 4 * hi);
            const float slc0 = diag ? 0.f : slc;
#pragma unroll
            for (int sub = 0; sub < 2; ++sub) {
#pragma unroll
                for (int r = 0; r < 16; ++r) s[sub][r] = __builtin_fmaf(slc0, (float)(32 * sub + (r & 3) + 8 * (r >> 2)), bias0);
#pragma unroll
                for (int j = 0; j < 4; ++j) {
                    const bf16x8 kf = *(const LAS bf16x8*)(Ks + (32 * sub + r32) * KROWB + (64 * comp + 16 * j + 8 * hi) * 2);
                    s[sub] = MFMA32(kf, qf[j], s[sub]);
                }
            }
            if (diag) {
#pragma unroll
                for (int sub = 0; sub < 2; ++sub)
#pragma unroll
                    for (int r = 0; r < 16; ++r) {
                        const int kv = kt * 64 + 32 * sub + crow(r, hi);
                        s[sub][r] += slc * ((float)tq - fabsf((float)(tq - kv)));
                    }
            }
            float mx = -1e30f;
#pragma unroll
            for (int sub = 0; sub < 2; ++sub)
#pragma unroll
                for (int r = 0; r < 16; r += 2) mx = __builtin_fmaxf(__builtin_fmaxf(mx, s[sub][r]), s[sub][r + 1]);
            mx = x32_max(mx);
            if (!__all((mx - mrun) * c1 < -150.0f)) {
            const float mnew = fmaxf(mrun, mx);
            const float f = fast_exp2((mrun - mnew) * c1);
            mrun = mnew; lrun *= f;
            if (__any(f != 1.0f)) {
#pragma unroll
                for (int i = 0; i < 4; ++i) O[i] = O[i] * f;
            }
            const float mc = -mnew * c1;
            bf16x8 pf[2][2];
            float ls = 0.f;
#pragma unroll
            for (int sub = 0; sub < 2; ++sub) {
#pragma unroll
                for (int r = 0; r < 16; ++r) { const float pv = fast_exp2(__builtin_fmaf(s[sub][r], c1, mc)); s[sub][r] = pv; ls += pv; }
#pragma unroll
                for (int s2 = 0; s2 < 2; ++s2) {
                    u32x4 w; w.x = pk2(s[sub][8 * s2 + 0], s[sub][8 * s2 + 1]); w.y = pk2(s[sub][8 * s2 + 2], s[sub][8 * s2 + 3]);
                    w.z = pk2(s[sub][8 * s2 + 4], s[sub][8 * s2 + 5]); w.w = pk2(s[sub][8 * s2 + 6], s[sub][8 * s2 + 7]);
                    pf[sub][s2] = __builtin_bit_cast(bf16x8, w);
                }
            }
            lrun += ls;
            {
#define VFRAG(blk_, q_) ({ const lptr vb_ = Vs + (32 * (blk_) + r32) * VROWB + 2 * (16 * (q_) + 4 * hi); const s16x4 lo_ = *(const LAS s16x4*)vb_, hi_ = *(const LAS s16x4*)(vb_ + 16); (bf16x8)__builtin_shufflevector(lo_, hi_, 0, 1, 2, 3, 4, 5, 6, 7); })
                bf16x8 vcur[4], vnxt[4];
#pragma unroll
                for (int q = 0; q < 4; ++q) vcur[q] = VFRAG(0, q);
#pragma unroll
                for (int blk = 0; blk < 4; ++blk) {
                    if (blk < 3) {
#pragma unroll
                        for (int q = 0; q < 4; ++q) vnxt[q] = VFRAG(blk + 1, q);
                    }
#pragma unroll
                    for (int q = 0; q < 4; ++q) O[blk] = MFMA32(vcur[q], pf[q >> 1][q & 1], O[blk]);
#pragma unroll
                    for (int q = 0; q < 4; ++q) vcur[q] = vnxt[q];
                }
#undef VFRAG
            }
            }
        } else {
#pragma unroll
            for (int subi = 0; subi < 2; ++subi) {
                const int sub = 1 - subi;
                if (kt == kt_d && sub > dsub) continue;
                const bool diag = (kt == kt_d && sub == dsub);
                f32x16 s;
#pragma unroll
                for (int r = 0; r < 16; ++r) s[r] = 0.f;
#pragma unroll
                for (int j = 0; j < 8; ++j) {
                    const bf16x8 kf = *(const LAS bf16x8*)(Ks + (32 * sub + r32) * KROWB + (16 * j + 8 * hi) * 2);
                    s = MFMA32(kf, qf[j], s);
                }
                const int kvbase = kt * 64 + 32 * sub;
                float lk[16], yl[16];
#pragma unroll
                for (int r = 0; r < 16; ++r) {
                    const float y = s[r] * c1;
                    const float e = fast_exp2(-fabsf(y));
                    const float L = fmaxf(y, 0.f) + fast_log2(1.0f + e);
                    const bool valid = !diag || (kvbase + crow(r, hi) < tq);
                    lk[r] = valid ? -L : 0.f;
                    yl[r] = valid ? (y - L) : -1e30f;
                }
                float gs[4], pgs[4];
#pragma unroll
                for (int g = 0; g < 4; ++g) { gs[g] = (lk[4 * g] + lk[4 * g + 1]) + (lk[4 * g + 2] + lk[4 * g + 3]); pgs[g] = x32_other(gs[g], hi); }
                const float T0 = gs[0] + pgs[0], T1 = gs[1] + pgs[1], T2 = gs[2] + pgs[2], T3 = gs[3] + pgs[3];
                float Sg[4]; Sg[3] = 0.f; Sg[2] = T3; Sg[1] = T3 + T2; Sg[0] = T3 + T2 + T1;
                float a[16];
#pragma unroll
                for (int g = 0; g < 4; ++g) {
                    float c = Crun + Sg[g] + (hi == 0 ? pgs[g] : 0.f);
                    a[4 * g + 3] = fast_exp2(yl[4 * g + 3] + c); c += lk[4 * g + 3];
                    a[4 * g + 2] = fast_exp2(yl[4 * g + 2] + c); c += lk[4 * g + 2];
                    a[4 * g + 1] = fast_exp2(yl[4 * g + 1] + c); c += lk[4 * g + 1];
                    a[4 * g + 0] = fast_exp2(yl[4 * g + 0] + c);
                }
                Crun += Sg[0] + T0;
                bf16x8 pf[2];
#pragma unroll
                for (int s2 = 0; s2 < 2; ++s2) {
                    u32x4 w; w.x = pk2(a[8 * s2 + 0], a[8 * s2 + 1]); w.y = pk2(a[8 * s2 + 2], a[8 * s2 + 3]);
                    w.z = pk2(a[8 * s2 + 4], a[8 * s2 + 5]); w.w = pk2(a[8 * s2 + 6], a[8 * s2 + 7]);
                    pf[s2] = __builtin_bit_cast(bf16x8, w);
                }
                {
#define VFRAG(blk_, s2_) ({ const lptr vb_ = Vs + (32 * (blk_) + r32) * VROWB + 2 * (32 * sub + 16 * (s2_) + 4 * hi); const s16x4 lo_ = *(const LAS s16x4*)vb_, hi_ = *(const LAS s16x4*)(vb_ + 16); (bf16x8)__builtin_shufflevector(lo_, hi_, 0, 1, 2, 3, 4, 5, 6, 7); })
                    bf16x8 vcur[2], vnxt[2];
                    vcur[0] = VFRAG(0, 0); vcur[1] = VFRAG(0, 1);
#pragma unroll
                    for (int blk = 0; blk < 4; ++blk) {
                        if (blk < 3) { vnxt[0] = VFRAG(blk + 1, 0); vnxt[1] = VFRAG(blk + 1, 1); }
                        O[blk] = MFMA32(vcur[0], pf[0], O[blk]); O[blk] = MFMA32(vcur[1], pf[1], O[blk]);
                        vcur[0] = vnxt[0]; vcur[1] = vnxt[1];
                    }
#undef VFRAG
                }
            }
            if (__all(Crun < -160.0f)) wdone = true;
        }
        }
        if (MODE) { if (lane == 0) stat[8 * (kt & 1) + wid] = wdone ? 1 : 0; }
    }
#undef ATT_STORE
#undef ATT_HEAD
    __builtin_amdgcn_s_setprio(0);
#undef ATT_LOAD
    if (MODE == 1) {
        bf16_t* orow = AO + (rowbase + tq) * DM + 512 + h * 128;
#pragma unroll
        for (int blk = 0; blk < 4; ++blk)
#pragma unroll
            for (int g = 0; g < 4; ++g) {
                u32x2 w; w.x = pk2(O[blk][4 * g], O[blk][4 * g + 1]); w.y = pk2(O[blk][4 * g + 2], O[blk][4 * g + 3]);
                *(u32x2*)(orow + 32 * blk + 8 * g + 4 * hi) = w;
            }
    } else {
        const float ltot = x32_sum(lrun);
        const float inv = 1.0f / ltot;
        LAS float* X = (LAS float*)(sm + OFF_X);
        if (wid >= 4) {
#pragma unroll
            for (int blk = 0; blk < 4; ++blk)
#pragma unroll
                for (int r = 0; r < 16; ++r) X[(((wid - 4) * 64 + blk * 16 + r) << 6) + lane] = O[blk][r] * inv;
        }
        __syncthreads();
        if (wid < 4) {
            float ss = 0.f;
#pragma unroll
            for (int blk = 0; blk < 4; ++blk)
#pragma unroll
                for (int r = 0; r < 16; ++r) { const float o = O[blk][r] * inv - lam * X[((wid * 64 + blk * 16 + r) << 6) + lane]; O[blk][r] = o; ss += o * o; }
            ss = x32_sum(ss);
            const float rs = rsqrtf(ss * (1.0f / 128.0f) + RMS_EPS) * (1.0f - lam_init);
            bf16_t* orow = AO + (rowbase + tq) * DM + h * 128;
#pragma unroll
            for (int blk = 0; blk < 4; ++blk)
#pragma unroll
                for (int g = 0; g < 4; ++g) {
                    const int dv = 32 * blk + 8 * g + 4 * hi;
                    const f32x4 wv = *(const f32x4*)(subln + dv);
                    u32x2 w; w.x = pk2(O[blk][4 * g] * rs * wv[0], O[blk][4 * g + 1] * rs * wv[1]); w.y = pk2(O[blk][4 * g + 2] * rs * wv[2], O[blk][4 * g + 3] * rs * wv[3]);
                    *(u32x2*)(orow + dv) = w;
                }
        }
    }
}

__device__ __forceinline__ void phase(const bf16_t* P, bf16_t* AO, const float* lamp, const float* subln, int layer, unsigned* ctr, lptr sm) {
    asm volatile("" : "+s"(layer));
    const float lam_init = 0.8f - 0.6f * expf(-0.3f * (float)layer);
    float d1 = 0.f, d2 = 0.f;
    for (int i = 0; i < 64; ++i) { d1 += lamp[i] * lamp[64 + i]; d2 += lamp[128 + i] * lamp[192 + i]; }
    const float lam = expf(d1) - expf(d2) + lam_init;
    LAS int* nxt = (LAS int*)(sm + OFF_STAT + 128);
    for (;;) {
        __syncthreads();
        if (threadIdx.x == 0) nxt[0] = (int)__hip_atomic_fetch_add(ctr, 1u, __ATOMIC_RELAXED, __HIP_MEMORY_SCOPE_AGENT);
        __syncthreads();
        const int u = nxt[0];
        if (u >= 768) break;
        if (u < 512) {
            const int hh = 3 - (u >> 7), v = u & 127;
            unit<0>(P, AO, v & 3, hh, 31 - (v >> 2), sm, lam, subln, lam_init);
        } else {
            const int w = u - 512, bh = w & 15;
            unit<1>(P, AO, bh >> 2, bh & 3, 15 - (w >> 4), sm, lam, subln, lam_init);
        }
    }
}
}

namespace gdn {
constexpr int PLD = 4096;
constexpr int RB = 272, TB = 144;
constexpr int OFF_QS = 0, OFF_KS = 64 * RB, OFF_KBT = OFF_KS + 64 * RB, OFF_VBT = OFF_KBT + 128 * TB, OFF_LF = OFF_VBT + 128 * TB, OFF_TF = OFF_LF + 64 * 65 * 4,
              OFF_MF = OFF_TF + 64 * 68 * 4, OFF_TBF = OFF_MF + 16 * 68 * 4, OFF_GC = OFF_TBF + 64 * TB, OFF_BETA = OFF_GC + 256, OFF_END = OFF_BETA + 256;
static_assert(OFF_END <= 131072, "gdn LDS");

__device__ __forceinline__ void chunk_phase(const bf16_t* P, const float* ABv, const float* convw, const float* alog, const float* dtb, unsigned char* ws, lptr sm) {
    const int tid = opaque_tid(), lane = tid & 63, wid = __builtin_amdgcn_readfirstlane(tid >> 6), r32 = lane & 31, hi = lane >> 5;
    LAS float* gcs = (LAS float*)(sm + OFF_GC); LAS float* betas = (LAS float*)(sm + OFF_BETA);
    LAS float* Lf = (LAS float*)(sm + OFF_LF); LAS float* Tf = (LAS float*)(sm + OFF_TF); LAS float* Mf = (LAS float*)(sm + OFF_MF);
    const int part = tid >> 7, o = tid & 15, tg = (tid & 127) >> 4;
    u32x4 xr[11]; float braw = 0.f, araw = 0.f;
#define CHUNK_PREFETCH(unx) do { const int n_ = (unx) & 63, h_ = ((unx) >> 6) & 7, b_ = (unx) >> 9; \
        if (part < 3) { const int ch_ = part * 1024 + h_ * 128 + 8 * o; \
            _Pragma("unroll") for (int rr = 0; rr < 11; ++rr) { const int sp = n_ * 64 + 8 * tg + rr - 3; \
                if (sp >= 0) xr[rr] = *(const u32x4*)(P + ((size_t)b_ * SEQ + sp) * PLD + ch_); else xr[rr] = (u32x4){0u, 0u, 0u, 0u}; } \
            } \
        if (tid < 64) { const size_t t_ = (size_t)b_ * SEQ + (size_t)n_ * 64 + tid; braw = ABv[t_ * 16 + h_]; araw = ABv[t_ * 16 + 8 + h_]; } } while (0)
    if ((int)blockIdx.x < 2048) CHUNK_PREFETCH((int)blockIdx.x);
#pragma nounroll
    for (int un = blockIdx.x; un < 2048; un += gridDim.x) {
    int tid_l = tid; asm volatile("" : "+v"(tid_l));
    const int tid = tid_l, lane = tid & 63, wid = __builtin_amdgcn_readfirstlane(tid >> 6), r32 = lane & 31, hi = lane >> 5;
    const int part = tid >> 7, o = tid & 15, tg = (tid & 127) >> 4;
    const int n = un & 63, h = (un >> 6) & 7, b = un >> 9;
    const size_t tok0 = (size_t)b * SEQ + (size_t)n * 64;
    f32x4 wq[8];
    if (part < 3) { const int ch = part * 1024 + h * 128 + 8 * o;
#pragma unroll
        for (int k = 0; k < 4; ++k) { wq[2 * k] = *(const f32x4*)(convw + (size_t)k * 3072 + ch); wq[2 * k + 1] = *(const f32x4*)(convw + (size_t)k * 3072 + ch + 4); } }
    BAR_LDS();
    if (tid < 64) {
        const float beta = 1.0f / (1.0f + expf(-braw));
        const float xx = araw + dtb[h];
        const float sp = fmaxf(xx, 0.f) + log1pf(expf(-fabsf(xx)));
        float g = -expf(alog[h]) * sp;
#pragma unroll
        for (int o2 = 1; o2 < 64; o2 <<= 1) { const float t = __shfl_up(g, o2); if (lane >= o2) g += t; }
        gcs[tid] = g; betas[tid] = beta;
    }
    for (int i = tid; i < 64 * 68; i += 512) Tf[i] = 0.f;
    BAR_LDS();
    const float gl = gcs[63];
    {
        if (part < 3) {
            float y[8][8];
#pragma unroll
            for (int i = 0; i < 8; ++i) {
#pragma unroll
                for (int c = 0; c < 8; ++c) {
                    float acc = 0.f;
#pragma unroll
                    for (int k = 0; k < 4; ++k) { const unsigned u = xr[i + k][c >> 1]; acc += wq[2 * k + (c >> 2)][c & 3] * ((c & 1) ? bf_hi(u) : bf_lo(u)); }
                    y[i][c] = silu_f(acc);
                }
            }
            if (part < 2) {
#pragma unroll
                for (int i = 0; i < 8; ++i) {
                    float ss = 0.f;
#pragma unroll
                    for (int c = 0; c < 8; ++c) ss += y[i][c] * y[i][c];
                    ss = row16_sum(ss);
                    const float rn = rsqrtf(ss + 1e-6f) * (part == 0 ? 0.08838834764831845f : 1.0f);
#pragma unroll
                    for (int c = 0; c < 8; ++c) y[i][c] *= rn;
                }
            }
            if (part == 0) {
                bf16_t* QD = (bf16_t*)(ws + WS_QD) + (size_t)un * 8192;
#pragma unroll
                for (int i = 0; i < 8; ++i) {
                    const int tk = 8 * tg + i; const float eg = fexp(gcs[tk]);
                    u32x4 w; w.x = pk2(y[i][0], y[i][1]); w.y = pk2(y[i][2], y[i][3]); w.z = pk2(y[i][4], y[i][5]); w.w = pk2(y[i][6], y[i][7]);
                    *(LAS u32x4*)(sm + OFF_QS + tk * RB + 16 * o) = w;
                    u32x4 d; d.x = pk2(y[i][0] * eg, y[i][1] * eg); d.y = pk2(y[i][2] * eg, y[i][3] * eg); d.z = pk2(y[i][4] * eg, y[i][5] * eg); d.w = pk2(y[i][6] * eg, y[i][7] * eg);
                    *(u32x4*)(QD + (((((tk >> 5) * 8 + (o >> 1)) * 64) + (tk & 31) + 32 * (o & 1)) << 3)) = d;
                }
            } else if (part == 1) {
                bf16_t* KDT = (bf16_t*)(ws + WS_KDT) + (size_t)un * 8192;
                float f1[8], f2[8];
#pragma unroll
                for (int i = 0; i < 8; ++i) { const int tk = 8 * tg + i; const float gi = gcs[tk]; f1[i] = betas[tk] * fexp(gi); f2[i] = fexp(gl - gi);
                    u32x4 w; w.x = pk2(y[i][0], y[i][1]); w.y = pk2(y[i][2], y[i][3]); w.z = pk2(y[i][4], y[i][5]); w.w = pk2(y[i][6], y[i][7]);
                    *(LAS u32x4*)(sm + OFF_KS + tk * RB + 16 * o) = w; }
#pragma unroll
                for (int c = 0; c < 8; ++c) {
                    u32x4 w; w.x = pk2(y[0][c] * f1[0], y[1][c] * f1[1]); w.y = pk2(y[2][c] * f1[2], y[3][c] * f1[3]); w.z = pk2(y[4][c] * f1[4], y[5][c] * f1[5]); w.w = pk2(y[6][c] * f1[6], y[7][c] * f1[7]);
                    *(LAS u32x4*)(sm + OFF_KBT + (8 * o + c) * TB + 16 * tg) = w;
                    u32x4 d; d.x = pk2(y[0][c] * f2[0], y[1][c] * f2[1]); d.y = pk2(y[2][c] * f2[2], y[3][c] * f2[3]); d.z = pk2(y[4][c] * f2[4], y[5][c] * f2[5]); d.w = pk2(y[6][c] * f2[6], y[7][c] * f2[7]);
                    { const int dk = 8 * o + c; *(u32x4*)(KDT + (((((dk >> 5) * 4 + (tg >> 1)) * 64) + (dk & 31) + 32 * (tg & 1)) << 3)) = d; }
                }
            } else {
                float f1[8];
#pragma unroll
                for (int i = 0; i < 8; ++i) f1[i] = betas[8 * tg + i];
#pragma unroll
                for (int c = 0; c < 8; ++c) {
                    u32x4 w; w.x = pk2(y[0][c] * f1[0], y[1][c] * f1[1]); w.y = pk2(y[2][c] * f1[2], y[3][c] * f1[3]); w.z = pk2(y[4][c] * f1[4], y[5][c] * f1[5]); w.w = pk2(y[6][c] * f1[6], y[7][c] * f1[7]);
                    *(LAS u32x4*)(sm + OFF_VBT + (8 * o + c) * TB + 16 * tg) = w;
                }
            }
        }
    }
    __syncthreads();
    { const int nu = un + (int)gridDim.x; if (nu < 2048) CHUNK_PREFETCH(nu); }
    {
        const int mat = wid >> 2, bi = (wid & 3) >> 1, bj = wid & 1;
        f32x16 s;
#pragma unroll
        for (int r = 0; r < 16; ++r) s[r] = 0.f;
#pragma unroll
        for (int jh = 0; jh < 2; ++jh) {
            bf16x8 af[4], bf[4];
#pragma unroll
            for (int j = 0; j < 4; ++j) {
                af[j] = *(const LAS bf16x8*)(sm + (mat ? OFF_QS : OFF_KS) + (32 * bi + r32) * RB + (16 * (4 * jh + j) + 8 * hi) * 2);
                bf[j] = *(const LAS bf16x8*)(sm + OFF_KS + (32 * bj + r32) * RB + (16 * (4 * jh + j) + 8 * hi) * 2);
            }
#pragma unroll
            for (int j = 0; j < 4; ++j) s = MFMA32(af[j], bf[j], s);
        }
        const int jj = 32 * bj + r32; const float gj = gcs[jj];
        bf16_t* AQK = (bf16_t*)(ws + WS_AQK) + (size_t)un * 4096;
#pragma unroll
        for (int r = 0; r < 16; ++r) {
            const int ii = 32 * bi + crow(r, hi);
            const float dec = fexp(fminf(gcs[ii] - gj, 0.f));
            if (mat == 0) Lf[ii * 65 + jj] = (ii > jj) ? betas[ii] * s[r] * dec : 0.f;
            else AQK[((((ii >> 5) * 4 + (jj >> 4)) * 64 + (ii & 31) + 32 * ((jj >> 3) & 1)) << 3) + (jj & 7)] = (bf16_t)(pk2((ii >= jj) ? s[r] * dec : 0.f, 0.f) & 0xffffu);
        }
    }
    __syncthreads();
    if (tid < 64) {
        const int I = tid >> 4, c = tid & 15;
        float x[16];
#pragma unroll
        for (int i = 0; i < 16; ++i) {
            float v = (i == c) ? 1.f : 0.f;
#pragma unroll
            for (int j = 0; j < i; ++j) v -= Lf[(16 * I + i) * 65 + 16 * I + j] * x[j];
            x[i] = v;
        }
#pragma unroll
        for (int i = 0; i < 16; ++i) Tf[(16 * I + i) * 68 + 16 * I + c] = x[i];
    }
    __syncthreads();
#pragma nounroll
    for (int I = 1; I < 4; ++I) {
        const int ng = 4 * I;
        if (tid < 16 * ng) {
            const int i = tid / ng, c4 = (tid % ng) * 4;
            f32x4 acc = {0.f, 0.f, 0.f, 0.f};
            const LAS float* lrow = Lf + (16 * I + i) * 65;
#pragma unroll 8
            for (int k = 0; k < 16 * I; ++k) acc += *(const LAS f32x4*)(Tf + k * 68 + c4) * lrow[k];
            *(LAS f32x4*)(Mf + i * 68 + c4) = acc;
        }
        __syncthreads();
        if (tid < 16 * ng) {
            const int i = tid / ng, c4 = (tid % ng) * 4;
            f32x4 acc = {0.f, 0.f, 0.f, 0.f};
            const LAS float* drow = Tf + (16 * I + i) * 68 + 16 * I;
#pragma unroll
            for (int k = 0; k < 16; ++k) acc += *(const LAS f32x4*)(Mf + k * 68 + c4) * drow[k];
            *(LAS f32x4*)(Tf + (16 * I + i) * 68 + c4) = -acc;
        }
        __syncthreads();
    }
    for (int e = tid; e < 64 * 32; e += 512) {
        const int i = e >> 5, j2 = (e & 31) * 2;
        *(LAS unsigned*)(sm + OFF_TBF + i * TB + j2 * 2) = pk2(Tf[i * 68 + j2], Tf[i * 68 + j2 + 1]);
    }
    __syncthreads();
    {
        const int mat = wid >> 2, bi = (wid & 3) >> 1;
        float* U = (float*)(ws + WS_U);
        bf16_t* WG = (bf16_t*)(ws + WS_WG) + (size_t)un * 8192;
#pragma unroll
        for (int cc = 0; cc < 2; ++cc) {
            const int bc = 2 * (wid & 1) + cc;
            f32x16 s;
#pragma unroll
            for (int r = 0; r < 16; ++r) s[r] = 0.f;
            {
                bf16x8 af[4], bf[4];
#pragma unroll
                for (int k = 0; k < 4; ++k) {
                    af[k] = *(const LAS bf16x8*)(sm + OFF_TBF + (32 * bi + r32) * TB + (16 * k + 8 * hi) * 2);
                    bf[k] = *(const LAS bf16x8*)(sm + (mat ? OFF_KBT : OFF_VBT) + (32 * bc + r32) * TB + (16 * k + 8 * hi) * 2);
                }
#pragma unroll
                for (int k = 0; k < 4; ++k) s = MFMA32(af[k], bf[k], s);
            }
#pragma unroll
            for (int r = 0; r < 16; ++r) {
                const int ii = 32 * bi + crow(r, hi), c = 32 * bc + r32;
                if (mat == 0) U[(tok0 + ii) * DM + h * 128 + c] = s[r];
                else WG[((((ii >> 5) * 8 + (c >> 4)) * 64 + (ii & 31) + 32 * ((c >> 3) & 1)) << 3) + (c & 7)] = (bf16_t)(pk2(s[r], 0.f) & 0xffffu);
            }
        }
    }
    if (tid == 0) ((float*)(ws + WS_CD))[un] = expf(gcs[63]);
    }
#undef CHUNK_PREFETCH
}

constexpr int OFF_ST = 0, OFF_VN = 32 * RB;
__device__ __forceinline__ void scan_task(int task, unsigned char* ws, bf16_t* OB, lptr sm) {
    const int tid = opaque_tid(), lane = tid & 63, wid = __builtin_amdgcn_readfirstlane(tid >> 6), r32 = lane & 31, hi = lane >> 5;
    const int bh = task >> 2, sl = task & 3, b = bh >> 3, h = bh & 7, e0 = 32 * sl;
    const int role = wid < 2 ? 0 : (wid < 4 ? 1 : 2);
    const int rb = wid < 2 ? wid : (wid < 4 ? wid - 2 : wid - 4);
    const bf16_t* WG = (const bf16_t*)(ws + WS_WG); const bf16_t* QD = (const bf16_t*)(ws + WS_QD); const bf16_t* KDT = (const bf16_t*)(ws + WS_KDT);
    const bf16_t* AQK = (const bf16_t*)(ws + WS_AQK); float* U = (float*)(ws + WS_U); const float* CD = (const float*)(ws + WS_CD);
    __syncthreads();
    for (int i = tid; i < (32 * RB + 32 * TB) / 4; i += 512) ((LAS unsigned*)sm)[i] = 0u;
    f32x16 Sacc;
#pragma unroll
    for (int r = 0; r < 16; ++r) Sacc[r] = 0.f;
    bf16x8 faA[8], faB[8], faC[8]; u32x4 fxA[4], fxB[4], fxC[4];
    const size_t ubase = ((size_t)b * SEQ + 32 * rb + 4 * hi) * DM + h * 128 + e0 + r32;
    const size_t abase = (size_t)bh * 64 * 8192 + ((size_t)rb * 512 + lane) * 8;
    const size_t kbase = (size_t)bh * 64 * 8192 + ((size_t)rb * 256 + lane) * 8;
    const size_t qbase = (size_t)bh * 64 * 4096 + ((size_t)rb * 256 + lane) * 8;
#define NCL(nn) ((nn) < 63 ? (nn) : 63)
#define LOAD_R0(nn, FA, FX) do { const int n_ = NCL(nn); \
        _Pragma("unroll") for (int j = 0; j < 8; ++j) FA[j] = *(const bf16x8*)(WG + abase + (size_t)n_ * 8192 + 512 * j); \
        _Pragma("unroll") for (int r = 0; r < 16; ++r) FX[r >> 2][r & 3] = __float_as_uint(U[ubase + (size_t)(n_ * 64 + (r & 3) + 8 * (r >> 2)) * DM]); } while (0)
#define LOAD_R1(nn, FA, FX) do { const int n_ = NCL(nn); \
        _Pragma("unroll") for (int j = 0; j < 8; ++j) FA[j] = *(const bf16x8*)(QD + abase + (size_t)n_ * 8192 + 512 * j); \
        _Pragma("unroll") for (int j = 0; j < 4; ++j) FX[j] = *(const u32x4*)(AQK + qbase + (size_t)n_ * 4096 + 512 * j); } while (0)
#define LOAD_R2(nn, FA, FX) do { const int n_ = NCL(nn); \
        _Pragma("unroll") for (int j = 0; j < 4; ++j) FA[j] = *(const bf16x8*)(KDT + kbase + (size_t)n_ * 8192 + 512 * j); FX[0][0] = __float_as_uint(CD[(size_t)bh * 64 + n_]); } while (0)
#define STEP_R0(nn, FA, FX, LFA, LFX) do { LOAD_R0((nn) + 2, LFA, LFX); \
        f32x16 acc; _Pragma("unroll") for (int r = 0; r < 16; ++r) acc[r] = 0.f; \
        _Pragma("unroll") for (int j = 0; j < 8; ++j) { const bf16x8 sb = *(const LAS bf16x8*)(sm + OFF_ST + r32 * RB + (16 * j + 8 * hi) * 2); acc = MFMA32(FA[j], sb, acc); } \
        _Pragma("unroll") for (int g = 0; g < 4; ++g) { \
            u32x2 w; w.x = pk2(__uint_as_float(FX[g][0]) - acc[4 * g], __uint_as_float(FX[g][1]) - acc[4 * g + 1]); w.y = pk2(__uint_as_float(FX[g][2]) - acc[4 * g + 2], __uint_as_float(FX[g][3]) - acc[4 * g + 3]); \
            *(LAS u32x2*)(sm + OFF_VN + r32 * TB + 2 * (32 * rb + 8 * g + 4 * hi)) = w; } \
        BAR_LDS(); BAR_LDS(); } while (0)
#define STEP_R1(nn, FA, FX, LFA, LFX) do { LOAD_R1((nn) + 2, LFA, LFX); \
        f32x16 acc; _Pragma("unroll") for (int r = 0; r < 16; ++r) acc[r] = 0.f; \
        _Pragma("unroll") for (int j = 0; j < 8; ++j) { const bf16x8 sb = *(const LAS bf16x8*)(sm + OFF_ST + r32 * RB + (16 * j + 8 * hi) * 2); acc = MFMA32(FA[j], sb, acc); } \
        BAR_LDS(); \
        _Pragma("unroll") for (int k = 0; k < 4; ++k) { const bf16x8 vb = *(const LAS bf16x8*)(sm + OFF_VN + r32 * TB + (16 * k + 8 * hi) * 2); acc = MFMA32(__builtin_bit_cast(bf16x8, FX[k]), vb, acc); } \
        _Pragma("unroll") for (int r = 0; r < 16; r += 2) { const unsigned w_ = pk2(acc[r], acc[r + 1]); OB[ubase + (size_t)((nn) * 64 + (r & 3) + 8 * (r >> 2)) * DM] = (bf16_t)(w_ & 0xffffu); OB[ubase + (size_t)((nn) * 64 + ((r + 1) & 3) + 8 * ((r + 1) >> 2)) * DM] = (bf16_t)(w_ >> 16); } \
        BAR_LDS(); } while (0)
#define STEP_R2(nn, FA, FX, LFA, LFX) do { LOAD_R2((nn) + 2, LFA, LFX); \
        BAR_LDS(); \
        Sacc = Sacc * __uint_as_float(FX[0][0]); \
        _Pragma("unroll") for (int k = 0; k < 4; ++k) { const bf16x8 vb = *(const LAS bf16x8*)(sm + OFF_VN + r32 * TB + (16 * k + 8 * hi) * 2); Sacc = MFMA32(FA[k], vb, Sacc); } \
        _Pragma("unroll") for (int g = 0; g < 4; ++g) { u32x2 w; w.x = pk2(Sacc[4 * g], Sacc[4 * g + 1]); w.y = pk2(Sacc[4 * g + 2], Sacc[4 * g + 3]); \
            *(LAS u32x2*)(sm + OFF_ST + r32 * RB + 2 * (32 * rb + 8 * g + 4 * hi)) = w; } \
        BAR_LDS(); } while (0)
#define ROLE_LOOP(LOADM, STEPM) do { LOADM(0, faA, fxA); LOADM(1, faB, fxB); BAR_LDS(); \
        _Pragma("nounroll") for (int n = 0; n < 64; n += 3) { STEPM(n, faA, fxA, faC, fxC); if (n + 1 < 64) { STEPM(n + 1, faB, fxB, faA, fxA); STEPM(n + 2, faC, fxC, faB, fxB); } } } while (0)
    if (role == 0) ROLE_LOOP(LOAD_R0, STEP_R0);
    else if (role == 1) ROLE_LOOP(LOAD_R1, STEP_R1);
    else ROLE_LOOP(LOAD_R2, STEP_R2);
#undef NCL
#undef LOAD_R0
#undef LOAD_R1
#undef LOAD_R2
#undef STEP_R0
#undef STEP_R1
#undef STEP_R2
#undef ROLE_LOOP
}

__device__ __forceinline__ void post_phase(const bf16_t* O, const bf16_t* P, const float* nw, bf16_t* H) {
    const int tid = opaque_tid(), lane = tid & 63, wave = tid >> 6;
    const int gw = blockIdx.x * 8 + wave, NGW = gridDim.x * 8;
    const f32x4 wv = *(const f32x4*)(nw + ((4 * lane) & 127));
    for (int m = gw; m < M; m += NGW) {
        const u32x2* orow = (const u32x2*)(O + (size_t)m * DM) + lane;
        const u32x2* grow = (const u32x2*)(P + (size_t)m * PLD + 3072) + lane;
        u32x2* hrow = (u32x2*)(H + (size_t)m * DM) + lane;
#pragma unroll
        for (int j = 0; j < 4; ++j) {
            const u32x2 ov = orow[64 * j]; const f32x4 v = {bf_lo(ov.x), bf_hi(ov.x), bf_lo(ov.y), bf_hi(ov.y)}; const u32x2 gq = grow[64 * j];
            float ss = (v[0] * v[0] + v[1] * v[1]) + (v[2] * v[2] + v[3] * v[3]);
            ss = x16_sum(row16_sum(ss));
            const float rs = rsqrtf(ss * (1.0f / 128.0f) + RMS_EPS);
            u32x2 o; o.x = pk2(v[0] * rs * wv[0] * silu_f(bf_lo(gq.x)), v[1] * rs * wv[1] * silu_f(bf_hi(gq.x)));
            o.y = pk2(v[2] * rs * wv[2] * silu_f(bf_lo(gq.y)), v[3] * rs * wv[3] * silu_f(bf_hi(gq.y)));
            hrow[64 * j] = o;
        }
    }
}
}


#define GAS __attribute__((address_space(1)))
#define XB_TMO      32
#define XB_XCNT(j)  (64   + 32 * (j))
#define XB_XSUB(j)  (576  + 32 * (j))
#define XB_XGEN(j)  (1088 + 32 * (j))
#define XB_TOP      1600
#define XB_TOPGEN   1632
#define XCD_BAR_WORDS 1664
#define XB_SPIN_CAP (1u << 18)

__device__ __forceinline__ unsigned xb_ld(unsigned* p)              { return __hip_atomic_load(p, __ATOMIC_RELAXED, __HIP_MEMORY_SCOPE_AGENT); }
__device__ __forceinline__ unsigned xb_add(unsigned* p, unsigned v) { return __hip_atomic_fetch_add(p, v, __ATOMIC_RELAXED, __HIP_MEMORY_SCOPE_AGENT); }
__device__ __forceinline__ unsigned xb_xcc_id() { return (unsigned)__builtin_amdgcn_s_getreg((3 << 11) | 20) & 0xFu; }
#define XB_SPIN(cond, bar) do { unsigned _sp = 0; while (cond) { __builtin_amdgcn_s_sleep(1); \
    if ((++_sp & 255u) == 0u) { if (xb_ld(&(bar)[XB_TMO])) break; if (_sp > XB_SPIN_CAP) { atomicAdd(&(bar)[XB_TMO], 1u); break; } } } } while (0)

struct XcdBarrier {
    unsigned* bar; unsigned x;
    volatile LAS unsigned* st;
};

__device__ __forceinline__ XcdBarrier xcd_barrier_post(unsigned* bar, volatile LAS unsigned* st) {
    XcdBarrier b; b.bar = bar; b.x = xb_xcc_id(); b.st = st;
    if (threadIdx.x == 0) (void)xb_add(&bar[XB_XCNT(b.x)], 1u);
    return b;
}
__device__ __forceinline__ void xcd_barrier_complete(unsigned* bar, unsigned x, unsigned& nloc, unsigned& nx) {
    const unsigned G = gridDim.x * gridDim.y * gridDim.z;
    unsigned sum, cnt, mine, sp = 0u;
    for (;;) {
        sum = 0u; cnt = 0u; mine = 0u;
#pragma unroll
        for (unsigned j = 0; j < 16; ++j) { const unsigned c = xb_ld(&bar[XB_XCNT(j)]); sum += c; cnt += (c > 0u) ? 1u : 0u; mine = (j == x) ? c : mine; }
        if (sum == G) break;
        __builtin_amdgcn_s_sleep(1);
        if ((++sp & 255u) == 0u) { if (xb_ld(&bar[XB_TMO])) break; if (sp > XB_SPIN_CAP) { atomicAdd(&bar[XB_TMO], 1u); break; } }
    }
    nloc = mine > 0u ? mine : 1u; nx = cnt > 0u ? cnt : 1u;
}

__device__ __forceinline__ void xcd_barrier(const XcdBarrier& b) {
    asm volatile("s_waitcnt vmcnt(0)" ::: "memory");
    __syncthreads();
    if (threadIdx.x == 0) {
        unsigned* bar = b.bar;
        __builtin_amdgcn_s_waitcnt(0);
        unsigned nloc = b.st[0], nx = b.st[1];
        if (nloc == 0u) { xcd_barrier_complete(bar, b.x, nloc, nx); b.st[0] = nloc; b.st[1] = nx; }
        const unsigned old = xb_add(&bar[XB_XSUB(b.x)], 1u);
        const unsigned gen = old / nloc;
        if (old + 1u == (gen + 1u) * nloc) {
            __builtin_amdgcn_fence(__ATOMIC_RELEASE, "agent");
            asm volatile("s_waitcnt vmcnt(0)" ::: "memory");
            const unsigned og = xb_add(&bar[XB_TOP], 1u);
            const unsigned tg = og / nx;
            if (og + 1u == (tg + 1u) * nx) xb_add(&bar[XB_TOPGEN], 1u);
            else XB_SPIN(xb_ld(&bar[XB_TOPGEN]) == tg, bar);
            __builtin_amdgcn_fence(__ATOMIC_ACQUIRE, "agent");
            xb_add(&bar[XB_XGEN(b.x)], 1u);
            asm volatile("s_waitcnt vmcnt(0)" ::: "memory");
        } else {
            XB_SPIN(xb_ld(&bar[XB_XGEN(b.x)]) == gen, bar);
            __builtin_amdgcn_fence(__ATOMIC_ACQUIRE, "agent");
            asm volatile("s_waitcnt vmcnt(0)" ::: "memory");
        }
    }
    __syncthreads();
}
#ifndef PM
#define PM 0xFFFF
#endif
#define GSYNC() do { xcd_barrier(xbar); if (PROBE & 0x1000) xcd_barrier(xbar); } while (0)
__global__ void __launch_bounds__(512, 2) fwd_megakernel(Params p) {
    cg::grid_group grid = cg::this_grid();
    grid.sync();
    const lptr lds = (lptr)lds_raw;
    volatile LAS unsigned* xst = (volatile LAS unsigned*)(lds + 139264);
    if (threadIdx.x == 0) { xst[0] = 0u; xst[1] = 0u; }
    __syncthreads();
    XcdBarrier xbar = xcd_barrier_post((unsigned*)(p.ws + WS_BAR), xst);
    unsigned char* ws = p.ws;
    bf16_t* H = (bf16_t*)p.out;
    bf16_t* XB = (bf16_t*)(ws + WS_H);
    bf16_t* PROJ = (bf16_t*)(ws + WS_R1);
    bf16_t* HID = (bf16_t*)(ws + WS_HID);
    float* ABv = (float*)(ws + WS_AB);
    float* SS = (float*)(ws + WS_SS);
#pragma nounroll
    for (int l = 0; l < 4; ++l) {
        const bool odd = l & 1; const int e = l >> 1;
#pragma nounroll
        for (int sbk = 0; sbk < 3; ++sbk) {
            const int ni = 3 * l + sbk;
            if (sbk != 1) {
                if (sbk == 0 && l == 0) {
                    convert_layer(p, 0, lds, 1, 0); __syncthreads();
                    prologue_phase(p.in[0], XB, SS);
                    GSYNC();
                }
                for (int rp = 0; rp < REPS(4); ++rp) { EpiSwiGLU E{HID, DFF, SS + (size_t)(ni & 1) * M * 16}; run_gemm(lds, XB, (const bf16_t*)(ws + (sbk == 0 ? WS_WGU1 : WS_WGU2)), 2 * DFF, DM, E); }
                if ((int)blockIdx.x >= (int)gridDim.x / 2) {
                    if (sbk == 0) convert_layer(p, l, lds, 2, (int)gridDim.x / 2);
                    else if (l < 3) convert_layer(p, l + 1, lds, 1, (int)gridDim.x / 2);
                }
                GSYNC();
                { EpiResid<true> E{XB, SS + (size_t)((ni + 1) & 1) * M * 16}; run_gemm(lds, HID, (const bf16_t*)(ws + (sbk == 0 ? WS_WD1 : WS_WD2)), DM, DFF, E); }
                GSYNC();
            } else {
                const float* nw = p.in[5] + (size_t)l * DM;
                if (odd) ab_phase(XB, nw, SS + (size_t)(ni & 1) * M * 16, p.in[10] + (size_t)e * DM * 4112 + 4096, ABv, lds);
                for (int rp = 0; rp < REPS(4); ++rp) { const int nin = odd ? 4096 : 3072; EpiBf16 E{PROJ, nin, SS + (size_t)(ni & 1) * M * 16}; run_gemm(lds, XB, (const bf16_t*)(ws + WS_WIN), nin, DM, E); }
                GSYNC();
                if (!odd) {
                    att::phase(PROJ, H, p.in[7] + (size_t)e * 256, p.in[8] + (size_t)e * 128, l, (unsigned*)(ws + WS_BAR + 14336) + 64 * e, lds);
                } else {
                    gdn::chunk_phase(PROJ, ABv, p.in[11] + (size_t)e * 4 * 3072, p.in[12] + e * 8, p.in[13] + e * 8, ws, lds);
                    GSYNC();
                    for (int rp = 0; rp < REPS(128); ++rp) for (int t = blockIdx.x; t < 128; t += gridDim.x) gdn::scan_task((((t & 7) * 4 + (t >> 5)) << 2) | ((t >> 3) & 3), ws, H, lds);
                    GSYNC();
                    gdn::post_phase(H, PROJ, p.in[14] + e * 128, H);
                }
                GSYNC();
                { EpiResid<false> E{XB, SS + (size_t)((ni + 1) & 1) * M * 16}; run_gemm(lds, H, (const bf16_t*)(ws + WS_WOUT), DM, DM, E); }
                GSYNC();
            }
        }
    }
    final_norm_phase(XB, p.out, p.in[20]);
}

extern "C" void kernel_launch(void* const* d_in, const int* in_sizes, int n_in, void* d_out, int out_size, void* d_ws, size_t ws_size, hipStream_t stream) {
    static int grid = 0;
    if (grid == 0) {
        if (n_in != 21 || out_size != M * DM || ws_size < WS_END) { fprintf(stderr, "kernel_launch: unexpected shapes (n_in %d out %d ws %zu, need %zu)\n", n_in, out_size, ws_size, (size_t)WS_END); grid = -1; return; }
        int dev = 0, cus = 0, per_cu = 0;
        hipGetDevice(&dev);
        hipDeviceGetAttribute(&cus, hipDeviceAttributeMultiprocessorCount, dev);
        if (hipFuncSetAttribute((const void*)fwd_megakernel, hipFuncAttributeMaxDynamicSharedMemorySize, LDS_BYTES) != hipSuccess) { fprintf(stderr, "kernel_launch: hipFuncSetAttribute failed\n"); grid = -1; return; }
        if (hipOccupancyMaxActiveBlocksPerMultiprocessor(&per_cu, (const void*)fwd_megakernel, 512, LDS_BYTES) != hipSuccess || per_cu < 1) { fprintf(stderr, "kernel_launch: occupancy query gave %d\n", per_cu); per_cu = 1; }
        (void)hipGetLastError();
        grid = cus * 1;
        if (grid > 256) grid = 256;
    }
    if (grid < 0) return;
    if (hipMemsetAsync((char*)d_ws + WS_BAR, 0, 16384, stream) != hipSuccess) { fprintf(stderr, "kernel_launch: memset failed\n"); return; }
    Params p{};
    for (int i = 0; i < 21; ++i) p.in[i] = (const float*)d_in[i];
    p.out = (float*)d_out; p.ws = (unsigned char*)d_ws;
    void* args[] = {&p};
    hipError_t e = hipLaunchCooperativeKernel((const void*)fwd_megakernel, dim3(grid), dim3(512), args, LDS_BYTES, stream);
    if (e != hipSuccess) fprintf(stderr, "cooperative launch failed: %s (grid %d)\n", hipGetErrorString(e), grid);
}
```

```cpp
#include <hip/hip_runtime.h>
#include <hip/hip_cooperative_groups.h>
#include <cstdio>
#include <cstdint>
namespace cg = cooperative_groups;
#ifndef PROBE
#define PROBE 0
#endif
#define REPS(bit) ((PROBE & (bit)) ? 2 : 1)
__device__ __forceinline__ int opaque_tid() { int t = (int)threadIdx.x; asm volatile("" : "+v"(t)); return t; }
namespace pg8 {
#define PG8_LAS __attribute__((address_space(3)))
typedef unsigned short bf16_t;
typedef short bf16x8 __attribute__((ext_vector_type(8)));
typedef float f32x4 __attribute__((ext_vector_type(4)));
typedef unsigned u32x4 __attribute__((ext_vector_type(4)));
constexpr int BM = 256, BK = 64, HALF = 128, HTB = HALF * BK * 2  , STAGE_BYTES = 8 * HTB, NXCD = 8, WGM = 8;

__host__ __device__ __forceinline__ int lds_byte(int r, int c) { const int st = (r >> 4) * 2 + (c >> 5), rr = r & 15, cc = c & 31, ob = rr * 64 + cc * 2; return st * 1024 + (ob ^ (((ob >> 9) & 1) << 5)); }
__host__ __device__ __forceinline__ void stage_rc(int b, int& R, int& C) { const int st = b / 1024, sb = b % 1024, swz = sb ^ (((sb >> 9) & 1) << 5); R = (st >> 1) * 16 + swz / 64; C = (st & 1) * 32 + (swz % 64) / 2; }
__host__ __device__ __forceinline__ int perm32(int rho) { const int n = rho >> 4, i = rho & 15; return 8 * (i >> 2) + 4 * n + (i & 3); }

struct Unit { int pm, pn; };
struct Gemm { const bf16_t* A; const bf16_t* Bt; int M, N, K; };

struct StaticOrder {
    int nM, nN, nwg, G, c;
    __host__ __device__ void init(int M, int N, int G_, int c_) { nM = M / BM; nN = N / BM; nwg = nM * nN; G = G_; c = c_; }
    __host__ __device__ bool next(int i, Unit& u) const {
        const long L = (long)i * G + c; if (L >= nwg) return false;
        int wgid = (int)L; { const int q = nwg / NXCD, r = nwg % NXCD, xcd = wgid % NXCD, off = wgid / NXCD; wgid = (xcd < r ? xcd * (q + 1) : r * (q + 1) + (xcd - r) * q) + off; }
        const int nig = WGM * nN, gid = wgid / nig, fm = gid * WGM, gsz = (nM - fm) < WGM ? (nM - fm) : WGM;
        u.pm = fm + ((wgid % nig) % gsz); u.pn = (wgid % nig) / gsz; return true;
    }
    __device__ __forceinline__ void a_ready(const Unit&) const {}
    __device__ __forceinline__ void done(const Unit&) const {}
};

template <class Epi, class Sched, bool ALIGN_EPI = false, bool SP2 = false>
__device__ __forceinline__ void gemm_phase(PG8_LAS unsigned char* lds, const Gemm g, const Sched& S, const Epi& E) {
    const int tid = opaque_tid(), wid = __builtin_amdgcn_readfirstlane(tid >> 6), lane = tid & 63, wr = wid >> 2, wc = wid & 3, fr = lane & 15, fq = lane >> 4;
    const int K = g.K, nt = K / BK;
    unsigned voffA[2], voffB[2];
#pragma unroll
    for (int i = 0; i < 2; ++i) { int R, C; stage_rc(tid * 16 + i * 8192, R, C); const int Rb = Epi::PERM ? ((R & ~31) + perm32(R & 31)) : R;
        voffA[i] = (unsigned)(R * K + C) * 2u; voffB[i] = (unsigned)(Rb * K + C) * 2u; }
    const size_t kstep = (size_t)(BK * 2);
    const size_t hstep = (size_t)HALF * K * 2;
    const size_t tstep = 2 * hstep;
    const unsigned ldsw = (unsigned)wid * 1024u;
    const int aoff = lds_byte(wr * 64 + fr, fq * 8), boff = lds_byte(wc * 32 + fr, fq * 8);
#define PG8_SA(b, h) (((b) * 2 + (h)) * HTB)
#define PG8_SB(b, h) ((4 + (b) * 2 + (h)) * HTB)
#define PG8_STAGE(bufoff, gbase, voff) do { _Pragma("unroll") for (int _i = 0; _i < 2; ++_i) \
        __builtin_amdgcn_global_load_lds((const unsigned*)((const char*)(gbase) + (voff)[_i]), (PG8_LAS unsigned*)(lds + (bufoff) + ldsw + _i * 8192), 16, 0, 0); } while (0)
#define PG8_LDA(dst, b, h) do { _Pragma("unroll") for (int m = 0; m < 4; ++m) _Pragma("unroll") for (int k = 0; k < 2; ++k) dst[m][k] = *(const PG8_LAS bf16x8*)(lds + PG8_SA(b, h) + aoff + m * 2048 + k * 1024); } while (0)
#define PG8_LDB(dst, b, h) do { _Pragma("unroll") for (int n = 0; n < 2; ++n) _Pragma("unroll") for (int k = 0; k < 2; ++k) dst[n][k] = *(const PG8_LAS bf16x8*)(lds + PG8_SB(b, h) + boff + n * 2048 + k * 1024); } while (0)
#define PG8_MMA(ai, bj, At, Bt) do { __builtin_amdgcn_s_setprio(1); _Pragma("unroll") for (int m = 0; m < 4; ++m) _Pragma("unroll") for (int n = 0; n < 2; ++n) _Pragma("unroll") for (int k = 0; k < 2; ++k) \
        acc[ai][bj][m][n] = __builtin_amdgcn_mfma_f32_16x16x32_bf16(Bt[n][k], At[m][k], acc[ai][bj][m][n], 0, 0, 0); __builtin_amdgcn_s_setprio(0); } while (0)
#define PG8_WAIT_V(n) asm volatile("s_waitcnt vmcnt(" #n ")" ::: "memory")
#define PG8_WAIT_L(n) asm volatile("s_waitcnt lgkmcnt(" #n ")" ::: "memory")
#define PG8_BAR __builtin_amdgcn_s_barrier()
#define PG8_SCHED __builtin_amdgcn_sched_barrier(0)
    Unit cur, nxt; int ui = 0;
    if (!S.next(0, cur)) return;
    f32x4 acc[2][2][4][2];
#pragma unroll
    for (int a = 0; a < 2; ++a)
#pragma unroll
        for (int b = 0; b < 2; ++b)
#pragma unroll
            for (int m = 0; m < 4; ++m)
#pragma unroll
                for (int n = 0; n < 2; ++n) acc[a][b][m][n] = (f32x4){0.f, 0.f, 0.f, 0.f};
    bf16x8 At[4][2], B0[2][2], B1[2][2];
    const char* cA = (const char*)g.A + (size_t)cur.pm * tstep; const char* cB = (const char*)g.Bt + (size_t)cur.pn * tstep;
    S.a_ready(cur);
    if constexpr (SP2) {
        PG8_STAGE(PG8_SB(0, 0), cB, voffB); PG8_STAGE(PG8_SB(0, 1), cB + hstep, voffB); PG8_STAGE(PG8_SA(0, 0), cA, voffA); PG8_STAGE(PG8_SA(0, 1), cA + hstep, voffA);
        if (wr == 1) PG8_BAR;
        PG8_WAIT_V(2); PG8_BAR;
        PG8_STAGE(PG8_SB(1, 0), cB + kstep, voffB); PG8_STAGE(PG8_SA(1, 0), cA + kstep, voffA); PG8_STAGE(PG8_SB(1, 1), cB + hstep + kstep, voffB);
        PG8_WAIT_V(6); PG8_BAR;
    } else {
        PG8_STAGE(PG8_SB(0, 0), cB, voffB); PG8_STAGE(PG8_SA(0, 0), cA, voffA); PG8_STAGE(PG8_SB(0, 1), cB + hstep, voffB); PG8_STAGE(PG8_SA(0, 1), cA + hstep, voffA);
        if (wr == 1) PG8_BAR;
        PG8_WAIT_V(4); PG8_BAR;
        PG8_STAGE(PG8_SB(1, 0), cB + kstep, voffB); PG8_STAGE(PG8_SA(1, 0), cA + kstep, voffA); PG8_STAGE(PG8_SB(1, 1), cB + hstep + kstep, voffB);
        PG8_WAIT_V(6); PG8_BAR;
    }
    for (;;) {
        const bool has_next = S.next(ui + 1, nxt);
        const char* nA = has_next ? (const char*)g.A + (size_t)nxt.pm * tstep : cA; const char* nB = has_next ? (const char*)g.Bt + (size_t)nxt.pn * tstep : cB;
        for (int t = 0; t < nt; t += 2) {
            const bool last = (t == nt - 2);
            const char* a1 = cA + (size_t)(t + 1) * kstep;
            const char* a2 = last ? nA : cA + (size_t)(t + 2) * kstep; const char* b2 = last ? nB : cB + (size_t)(t + 2) * kstep;
            const char* a3 = a2 + kstep; const char* b3 = b2 + kstep;
            if (last && has_next) S.a_ready(nxt);
            if constexpr (SP2) {
            PG8_LDB(B0, 0, 0); PG8_LDB(B1, 0, 1); PG8_SCHED; PG8_LDA(At, 0, 0); PG8_STAGE(PG8_SA(1, 1), a1 + hstep, voffA);
            PG8_WAIT_V(8); PG8_WAIT_L(0); PG8_BAR; PG8_MMA(0, 0, At, B0); PG8_MMA(0, 1, At, B1); PG8_BAR; PG8_SCHED;
            PG8_LDA(At, 0, 1); PG8_STAGE(PG8_SB(0, 0), b2, voffB); PG8_STAGE(PG8_SB(0, 1), b2 + hstep, voffB); PG8_STAGE(PG8_SA(0, 0), a2, voffA);
            PG8_WAIT_V(8); PG8_WAIT_L(0); PG8_BAR; PG8_MMA(1, 0, At, B0); PG8_MMA(1, 1, At, B1); PG8_BAR; PG8_SCHED;
            PG8_LDB(B0, 1, 0); PG8_LDB(B1, 1, 1); PG8_SCHED; PG8_LDA(At, 1, 0); PG8_STAGE(PG8_SA(0, 1), a2 + hstep, voffA);
            PG8_WAIT_V(8); PG8_WAIT_L(0); PG8_BAR; PG8_MMA(0, 0, At, B0); PG8_MMA(0, 1, At, B1); PG8_BAR; PG8_SCHED;
            PG8_LDA(At, 1, 1); PG8_STAGE(PG8_SB(1, 0), b3, voffB); PG8_STAGE(PG8_SB(1, 1), b3 + hstep, voffB); PG8_STAGE(PG8_SA(1, 0), a3, voffA);
            PG8_WAIT_V(8); PG8_WAIT_L(0); PG8_BAR; PG8_MMA(1, 0, At, B0); PG8_MMA(1, 1, At, B1); PG8_BAR; PG8_SCHED;
            } else {
            PG8_LDB(B0, 0, 0); PG8_SCHED; PG8_LDA(At, 0, 0); PG8_STAGE(PG8_SA(1, 1), a1 + hstep, voffA);
            PG8_WAIT_L(8); PG8_BAR; PG8_WAIT_L(0); PG8_MMA(0, 0, At, B0); PG8_BAR; PG8_SCHED;
            PG8_LDB(B1, 0, 1); PG8_STAGE(PG8_SB(0, 0), b2, voffB);
            PG8_BAR; PG8_WAIT_L(0); PG8_MMA(0, 1, At, B1); PG8_BAR;
            PG8_LDA(At, 0, 1); PG8_STAGE(PG8_SA(0, 0), a2, voffA);
            PG8_BAR; PG8_WAIT_L(0); PG8_MMA(1, 0, At, B0); PG8_BAR; PG8_SCHED;
            PG8_STAGE(PG8_SB(0, 1), b2 + hstep, voffB);
            PG8_WAIT_V(6); PG8_BAR; PG8_MMA(1, 1, At, B1); PG8_BAR;
            PG8_LDB(B0, 1, 0); PG8_SCHED; PG8_LDA(At, 1, 0); PG8_STAGE(PG8_SA(0, 1), a2 + hstep, voffA);
            PG8_WAIT_L(8); PG8_BAR; PG8_WAIT_L(0); PG8_MMA(0, 0, At, B0); PG8_BAR; PG8_SCHED;
            PG8_LDB(B1, 1, 1); PG8_STAGE(PG8_SB(1, 0), b3, voffB);
            PG8_BAR; PG8_WAIT_L(0); PG8_MMA(0, 1, At, B1); PG8_BAR;
            PG8_LDA(At, 1, 1); PG8_STAGE(PG8_SA(1, 0), a3, voffA);
            PG8_BAR; PG8_WAIT_L(0); PG8_MMA(1, 0, At, B0); PG8_BAR; PG8_SCHED;
            PG8_STAGE(PG8_SB(1, 1), b3 + hstep, voffB);
            PG8_WAIT_V(6); PG8_BAR; PG8_MMA(1, 1, At, B1); PG8_BAR;
            }
        }
        if constexpr (ALIGN_EPI) { if (wr == 0) PG8_BAR; }
        if constexpr (!Epi::AFTER_DRAIN) { E(acc, cur, wr, wc, fr, fq); S.done(cur); }
        if (!has_next) break;
#pragma unroll
        for (int a = 0; a < 2; ++a)
#pragma unroll
            for (int b = 0; b < 2; ++b)
#pragma unroll
                for (int m = 0; m < 4; ++m)
#pragma unroll
                    for (int n = 0; n < 2; ++n) acc[a][b][m][n] = (f32x4){0.f, 0.f, 0.f, 0.f};
        cur = nxt; cA = nA; cB = nB; ++ui;
        if constexpr (ALIGN_EPI) { if (wr == 1) PG8_BAR; }
    }
    PG8_WAIT_V(0);
    if constexpr (!ALIGN_EPI) { if (wr == 0) PG8_BAR; }
    PG8_BAR;
    if constexpr (Epi::AFTER_DRAIN) { E.fused(acc, cur, wr, wc, fr, fq, lds, wid, lane); S.done(cur); }
#undef PG8_SA
#undef PG8_SB
#undef PG8_STAGE
#undef PG8_LDA
#undef PG8_LDB
#undef PG8_MMA
#undef PG8_WAIT_V
#undef PG8_WAIT_L
#undef PG8_BAR
#undef PG8_SCHED
}
}

#define LAS __attribute__((address_space(3)))
typedef unsigned short bf16_t;
typedef short bf16x8 __attribute__((ext_vector_type(8)));
typedef short s16x4 __attribute__((ext_vector_type(4)));
typedef float f32x4 __attribute__((ext_vector_type(4)));
typedef float f32x16 __attribute__((ext_vector_type(16)));
typedef unsigned u32x4 __attribute__((ext_vector_type(4)));
typedef unsigned u32x2 __attribute__((ext_vector_type(2)));
typedef float f32x2_t __attribute__((ext_vector_type(2)));
typedef __bf16 bf16x2_t __attribute__((ext_vector_type(2)));
typedef LAS unsigned char* lptr;
#define BAR_LDS() asm volatile("s_waitcnt lgkmcnt(0)\n\ts_barrier" ::: "memory")
#define MFMA32(a, b, c) __builtin_amdgcn_mfma_f32_32x32x16_bf16((a), (b), (c), 0, 0, 0)

constexpr int BATCH = 4, SEQ = 4096, DM = 1024, DFF = 2816, M = BATCH * SEQ;
constexpr float RMS_EPS = 1e-6f, LOG2E = 1.4426950408889634f;
constexpr size_t MiB = 1u << 20;
constexpr size_t WS_WGU1 = 0, WS_WD1 = 11534336, WS_WIN = 17301504, WS_WOUT = 25690112, WS_WGU2 = 27787264, WS_WD2 = 39321600;
constexpr size_t WS_H = 48 * MiB, WS_AB = 80 * MiB, WS_CD = 81 * MiB, WS_BAR = 81 * MiB + 512 * 1024, WS_R1 = 82 * MiB, WS_R2 = 210 * MiB;
constexpr size_t WS_HID = WS_R2, WS_WG = WS_R2, WS_QD = WS_R2 + 32 * MiB, WS_KDT = WS_R2 + 64 * MiB, WS_AQK = WS_R2 + 96 * MiB, WS_U = WS_R2 + 112 * MiB, WS_END = WS_R2 + 176 * MiB;
constexpr size_t WS_XB = WS_R2 + 96 * MiB;
constexpr size_t WS_SS = 44 * MiB;
constexpr int LDS_BYTES = 147456;

__device__ __forceinline__ unsigned pk2(float lo, float hi) { f32x2_t v = {lo, hi}; bf16x2_t b = __builtin_convertvector(v, bf16x2_t); return __builtin_bit_cast(unsigned, b); }
__device__ __forceinline__ float bf_lo(unsigned u) { return __uint_as_float(u << 16); }
__device__ __forceinline__ float bf_hi(unsigned u) { return __uint_as_float(u & 0xffff0000u); }
template <int CTRL> __device__ __forceinline__ float dpp_f(float v) { return __uint_as_float((unsigned)__builtin_amdgcn_update_dpp(0, (int)__float_as_uint(v), CTRL, 0xf, 0xf, false)); }
__device__ __forceinline__ float row16_sum(float v) { v += dpp_f<0x128>(v); v += dpp_f<0x124>(v); v += dpp_f<0x122>(v); v += dpp_f<0x121>(v); return v; }
__device__ __forceinline__ float x16_sum(float v) { auto rr = __builtin_amdgcn_permlane16_swap(__float_as_uint(v), __float_as_uint(v), false, false); return __uint_as_float(rr[0]) + __uint_as_float(rr[1]); }
__device__ __forceinline__ float x32_sum(float v) { auto rr = __builtin_amdgcn_permlane32_swap(__float_as_uint(v), __float_as_uint(v), false, false); return __uint_as_float(rr[0]) + __uint_as_float(rr[1]); }
__device__ __forceinline__ float x32_max(float v) { auto rr = __builtin_amdgcn_permlane32_swap(__float_as_uint(v), __float_as_uint(v), false, false); return fmaxf(__uint_as_float(rr[0]), __uint_as_float(rr[1])); }
__device__ __forceinline__ float x32_other(float v, int hi) { auto rr = __builtin_amdgcn_permlane32_swap(__float_as_uint(v), __float_as_uint(v), false, false); return __uint_as_float(hi ? rr[0] : rr[1]); }
__device__ __forceinline__ float wave_sum(float v) { return x32_sum(x16_sum(row16_sum(v))); }
__device__ __forceinline__ int crow(int r, int hi) { return (r & 3) + 8 * (r >> 2) + 4 * hi; }
__device__ __forceinline__ float fast_exp2(float x) { return __builtin_amdgcn_exp2f(x); }
__device__ __forceinline__ float fast_log2(float x) { return __builtin_amdgcn_logf(x); }
__device__ __forceinline__ float fexp(float x) { return __builtin_amdgcn_exp2f(x * LOG2E); }
__device__ __forceinline__ float silu_f(float g) { return g * __builtin_amdgcn_rcpf(1.0f + __expf(-g)); }

__device__ __forceinline__ float row_rstd(const float* ss, int row) {
    const f32x4* q = (const f32x4*)(ss + (size_t)row * 16); const f32x4 a = q[0], b = q[1], c = q[2], d = q[3];
    const float t = ((a[0] + a[1]) + (a[2] + a[3])) + ((b[0] + b[1]) + (b[2] + b[3])) + ((c[0] + c[1]) + (c[2] + c[3])) + ((d[0] + d[1]) + (d[2] + d[3]));
    return rsqrtf(t * (1.f / DM) + RMS_EPS);
}
extern __shared__ __attribute__((aligned(16))) unsigned char lds_raw[];
constexpr int RS_TAB_OFF = 132096, RS_PM_OFF = 136192;
__device__ __forceinline__ const LAS float* rstd_table(const float* ss, int pm, int wr, int wc, int lane) {
    const lptr l0 = (lptr)lds_raw;
    const int wave = wr * 4 + wc;
    LAS float* tab = (LAS float*)(l0 + RS_TAB_OFF + wave * 512);
    LAS int* cpm = (LAS int*)(l0 + RS_PM_OFF + wave * 4);
    if (cpm[0] != pm) {
        tab[lane] = row_rstd(ss, pm * 256 + wr * 64 + lane);
        tab[64 + lane] = row_rstd(ss, pm * 256 + 128 + wr * 64 + lane);
        if (lane == 0) cpm[0] = pm;
        asm volatile("s_waitcnt lgkmcnt(0)" ::: "memory");
    }
    return tab;
}
struct EpiSwiGLU {
    static constexpr bool PERM = true, AFTER_DRAIN = false;
    bf16_t* O; int ldc; const float* ss;
    __device__ __forceinline__ void operator()(const pg8::f32x4 (&acc)[2][2][4][2], const pg8::Unit& u, int wr, int wc, int fr, int fq) const {
        const int row0 = u.pm * 256 + wr * 64 + fr, col0 = u.pn * 128 + wc * 32 + 8 * fq;
        const LAS float* tab = rstd_table(ss, u.pm, wr, wc, fr + 16 * fq);
#pragma unroll
        for (int ai = 0; ai < 2; ++ai)
#pragma unroll
            for (int m = 0; m < 4; ++m) {
                const int row = row0 + ai * 128 + m * 16;
                const float rs = tab[64 * ai + 16 * m + fr];
                bf16_t* rowp = O + (size_t)row * ldc + col0;
                const pg8::f32x4 g0 = acc[ai][0][m][0] * rs, g1 = acc[ai][0][m][1] * rs, u0 = acc[ai][1][m][0] * rs, u1 = acc[ai][1][m][1] * rs;
                u32x4 w;
                w.x = pk2(silu_f(g0[0]) * u0[0], silu_f(g0[1]) * u0[1]); w.y = pk2(silu_f(g0[2]) * u0[2], silu_f(g0[3]) * u0[3]);
                w.z = pk2(silu_f(g1[0]) * u1[0], silu_f(g1[1]) * u1[1]); w.w = pk2(silu_f(g1[2]) * u1[2], silu_f(g1[3]) * u1[3]);
                *(u32x4*)rowp = w;
            }
    }
};
template <bool HALF> struct EpiResid {
    static constexpr bool PERM = true, AFTER_DRAIN = false;
    static constexpr float s = HALF ? 0.5f : 1.0f;
    bf16_t* xb; float* ssn;
    __device__ __forceinline__ void operator()(const pg8::f32x4 (&acc)[2][2][4][2], const pg8::Unit& u, int wr, int wc, int fr, int fq) const {
        const int row0 = u.pm * 256 + wr * 64 + fr, col0 = u.pn * 256 + wc * 32 + 8 * fq;
#pragma unroll
        for (int ai = 0; ai < 2; ++ai)
#pragma unroll
            for (int m = 0; m < 4; ++m) {
                const int row = row0 + ai * 128 + m * 16;
                bf16_t* rowp = xb + (size_t)row * DM + col0;
                float q = 0.f;
#pragma unroll
                for (int bj = 0; bj < 2; ++bj) {
                    const u32x4 bb = *(const u32x4*)(rowp + bj * 128);
                    const pg8::f32x4 b0 = {bf_lo(bb.x), bf_hi(bb.x), bf_lo(bb.y), bf_hi(bb.y)}, b1 = {bf_lo(bb.z), bf_hi(bb.z), bf_lo(bb.w), bf_hi(bb.w)};
                    const pg8::f32x4 v0 = b0 + acc[ai][bj][m][0] * s, v1 = b1 + acc[ai][bj][m][1] * s;
                    u32x4 w; w.x = pk2(v0[0], v0[1]); w.y = pk2(v0[2], v0[3]); w.z = pk2(v1[0], v1[1]); w.w = pk2(v1[2], v1[3]);
                    *(u32x4*)(rowp + bj * 128) = w;
                    q += ((v0[0] * v0[0] + v0[1] * v0[1]) + (v0[2] * v0[2] + v0[3] * v0[3])) + ((v1[0] * v1[0] + v1[1] * v1[1]) + (v1[2] * v1[2] + v1[3] * v1[3]));
                }
                q = x32_sum(x16_sum(q));
                if (fq == 0) ssn[(size_t)row * 16 + u.pn * 4 + wc] = q;
            }
    }
};
struct EpiBf16 {
    static constexpr bool PERM = true, AFTER_DRAIN = false;
    bf16_t* O; int ldc; const float* ss;
    __device__ __forceinline__ void operator()(const pg8::f32x4 (&acc)[2][2][4][2], const pg8::Unit& u, int wr, int wc, int fr, int fq) const {
        const int row0 = u.pm * 256 + wr * 64 + fr, col0 = u.pn * 256 + wc * 32 + 8 * fq;
        const LAS float* tab = rstd_table(ss, u.pm, wr, wc, fr + 16 * fq);
#pragma unroll
        for (int ai = 0; ai < 2; ++ai)
#pragma unroll
            for (int m = 0; m < 4; ++m) {
                const int row = row0 + ai * 128 + m * 16;
                const float rs = tab[64 * ai + 16 * m + fr];
                bf16_t* rowp = O + (size_t)row * ldc + col0;
#pragma unroll
                for (int bj = 0; bj < 2; ++bj) {
                    const pg8::f32x4 v0 = acc[ai][bj][m][0] * rs, v1 = acc[ai][bj][m][1] * rs;
                    u32x4 w; w.x = pk2(v0[0], v0[1]); w.y = pk2(v0[2], v0[3]); w.z = pk2(v1[0], v1[1]); w.w = pk2(v1[2], v1[3]);
                    *(u32x4*)(rowp + bj * 128) = w;
                }
            }
    }
};
template <class Epi>
__device__ __forceinline__ void run_gemm(lptr lds, const bf16_t* A, const bf16_t* Bt, int N, int K, const Epi& E) {
    { const int t_ = opaque_tid(); if ((t_ & 63) == 0) *(LAS int*)(lds + RS_PM_OFF + (t_ >> 6) * 4) = -1; }
    pg8::Gemm g{A, Bt, M, N, K}; pg8::StaticOrder S; S.init(M, N, (int)gridDim.x, (int)blockIdx.x);
    pg8::gemm_phase<Epi, pg8::StaticOrder, true, true>(lds, g, S, E);
}

__device__ __forceinline__ void tr_item(const float* W, int ldw, int k0, int n0, bf16_t* WT, int K, int drow0, LAS float* scr, int lane, const float* nw) {
    float tv[32];
#pragma unroll
    for (int i = 0; i < 32; ++i) tv[i] = W[(size_t)(k0 + 2 * i + (lane >> 5)) * ldw + n0 + (lane & 31)];
#pragma unroll
    for (int i = 0; i < 32; ++i) scr[(2 * i + (lane >> 5)) * 33 + (lane & 31)] = nw ? tv[i] * nw[k0 + 2 * i + (lane >> 5)] : tv[i];
    asm volatile("s_waitcnt lgkmcnt(0)" ::: "memory");
    const int c = lane & 7;
#pragma unroll
    for (int j = 0; j < 4; ++j) {
        const int n = (lane >> 3) + 8 * j; const LAS float* s = scr + (8 * c) * 33 + n;
        u32x4 o; o.x = pk2(s[0 * 33], s[1 * 33]); o.y = pk2(s[2 * 33], s[3 * 33]); o.z = pk2(s[4 * 33], s[5 * 33]); o.w = pk2(s[6 * 33], s[7 * 33]);
        *(u32x4*)(WT + (size_t)(drow0 + n) * K + k0 + 8 * c) = o;
    }
    asm volatile("s_waitcnt lgkmcnt(0)" ::: "memory");
}
struct Params { const float* in[21]; float* out; unsigned char* ws; };

__device__ __forceinline__ void convert_layer(const Params& p, int l, lptr lds, int part, int b0) {
    const int tid = opaque_tid(), lane = tid & 63, wave = tid >> 6;
    LAS float* scr = (LAS float*)(lds + wave * 16384);
    const int gw = ((int)blockIdx.x - b0) * 8 + wave, NGW = ((int)gridDim.x - b0) * 8;
    const bool odd = l & 1; const int e = l >> 1;
    const float* Win = odd ? p.in[10] + (size_t)e * DM * 4112 : p.in[6] + (size_t)e * DM * 3072;
    const int ldin = odd ? 4112 : 3072, nin = odd ? 4096 : 3072;
    const float* Wout = odd ? p.in[15] + (size_t)e * DM * DM : p.in[9] + (size_t)e * DM * DM;
    const int I_G = (DM / 64) * (DFF / 32), I_D = (DFF / 64) * (DM / 32), I_IN = (DM / 64) * (nin / 32), I_OUT = (DM / 64) * (DM / 32);
    const int n1 = 2 * I_G + I_D, total = 4 * I_G + 2 * I_D + I_IN + I_OUT;
    for (int it = (part == 1 ? 0 : n1) + gw; it < (part == 1 ? n1 : total); it += NGW) {
        int r = it;
#define SEG(Wp, LDW, KK, NITEMS, NBLK, WTOFF, MODE, NW) \
        if (r < (NITEMS)) { const int kb = r / (NBLK), nb = r % (NBLK); const int n0 = 32 * nb; \
            const int dr = (MODE) == 0 ? n0 : ((n0 >> 7) * 256 + (n0 & 127) + ((MODE) == 2 ? 128 : 0)); \
            tr_item((Wp), (LDW), 64 * kb, n0, (bf16_t*)(p.ws + (WTOFF)), (KK), dr, scr, lane, (NW)); continue; } r -= (NITEMS);
        SEG(p.in[2] + (size_t)l * DM * DFF, DFF, DM, I_G, DFF / 32, WS_WGU1, 1, p.in[1] + (size_t)l * DM)
        SEG(p.in[3] + (size_t)l * DM * DFF, DFF, DM, I_G, DFF / 32, WS_WGU1, 2, p.in[1] + (size_t)l * DM)
        SEG(p.in[4] + (size_t)l * DM * DFF, DM, DFF, I_D, DM / 32, WS_WD1, 0, (const float*)nullptr)
        if (odd) { SEG(Win, 4112, DM, 2048, 128, WS_WIN, 0, p.in[5] + (size_t)l * DM) } else { SEG(Win, 3072, DM, 1536, 96, WS_WIN, 0, p.in[5] + (size_t)l * DM) }
        SEG(Wout, DM, DM, I_OUT, DM / 32, WS_WOUT, 0, (const float*)nullptr)
        SEG(p.in[17] + (size_t)l * DM * DFF, DFF, DM, I_G, DFF / 32, WS_WGU2, 1, p.in[16] + (size_t)l * DM)
        SEG(p.in[18] + (size_t)l * DM * DFF, DFF, DM, I_G, DFF / 32, WS_WGU2, 2, p.in[16] + (size_t)l * DM)
        SEG(p.in[19] + (size_t)l * DM * DFF, DM, DFF, I_D, DM / 32, WS_WD2, 0, (const float*)nullptr)
#undef SEG
    }
}

__device__ __forceinline__ void prologue_phase(const float* X, bf16_t* XB, float* ss) {
    const int tid = opaque_tid(), lane = tid & 63, wave = tid >> 6;
    const int gw = blockIdx.x * 8 + wave, NGW = gridDim.x * 8;
    for (int m = gw; m < M; m += NGW) {
        const f32x4* xr = (const f32x4*)(X + (size_t)m * DM) + lane;
        f32x4 v[4]; float s = 0.f;
#pragma unroll
        for (int j = 0; j < 4; ++j) { v[j] = xr[64 * j]; s += (v[j][0] * v[j][0] + v[j][1] * v[j][1]) + (v[j][2] * v[j][2] + v[j][3] * v[j][3]); }
        s = wave_sum(s);
        u32x2* o8 = (u32x2*)(XB + (size_t)m * DM) + lane;
#pragma unroll
        for (int j = 0; j < 4; ++j) { u32x2 o; o.x = pk2(v[j][0], v[j][1]); o.y = pk2(v[j][2], v[j][3]); o8[64 * j] = o; }
        if (lane < 16) ss[(size_t)m * 16 + lane] = lane == 0 ? s : 0.f;
    }
}
__device__ __forceinline__ void ab_phase(const bf16_t* XBp, const float* w, const float* ss, const float* W16src, float* ABout, lptr lds) {
    const int tid = opaque_tid(), lane = tid & 63, wave = tid >> 6;
    const int gw = blockIdx.x * 8 + wave, NGW = gridDim.x * 8;
    LAS float* W16t = (LAS float*)lds;
    for (int k = tid; k < DM; k += 512) {
        const f32x4* src = (const f32x4*)(W16src + (size_t)k * 4112);
#pragma unroll
        for (int q = 0; q < 4; ++q) { const f32x4 v = src[q]; W16t[(4 * q + 0) * 1024 + k] = v[0]; W16t[(4 * q + 1) * 1024 + k] = v[1]; W16t[(4 * q + 2) * 1024 + k] = v[2]; W16t[(4 * q + 3) * 1024 + k] = v[3]; }
    }
    __syncthreads();
    f32x4 wv[4];
#pragma unroll
    for (int j = 0; j < 4; ++j) wv[j] = ((const f32x4*)w)[64 * j + lane];
    for (int m = gw; m < M; m += NGW) {
        const u32x2* xr = (const u32x2*)(XBp + (size_t)m * DM) + lane;
        const float rstd = row_rstd(ss, m);
        f32x4 v[4];
#pragma unroll
        for (int j = 0; j < 4; ++j) { const u32x2 t = xr[64 * j]; const f32x4 xv = {bf_lo(t.x), bf_hi(t.x), bf_lo(t.y), bf_hi(t.y)}; v[j] = xv * rstd * wv[j]; }
        float mine = 0.f;
#pragma nounroll
        for (int c = 0; c < 16; ++c) {
            float a = 0.f;
#pragma unroll
            for (int j = 0; j < 4; ++j) { const f32x4 t = *(const LAS f32x4*)(W16t + c * 1024 + 256 * j + 4 * lane); a += (v[j][0] * t[0] + v[j][1] * t[1]) + (v[j][2] * t[2] + v[j][3] * t[3]); }
            a = wave_sum(a);
            if (lane == c) mine = a;
        }
        if (lane < 16) ABout[(size_t)m * 16 + lane] = mine;
    }
    __syncthreads();
}
__device__ __forceinline__ void final_norm_phase(const bf16_t* XBp, float* out, const float* w) {
    const int tid = opaque_tid(), lane = tid & 63, wave = tid >> 6;
    const int gw = blockIdx.x * 8 + wave, NGW = gridDim.x * 8;
    f32x4 wv[4];
#pragma unroll
    for (int j = 0; j < 4; ++j) wv[j] = ((const f32x4*)w)[64 * j + lane];
    for (int m = gw; m < M; m += NGW) {
        const u32x2* xr = (const u32x2*)(XBp + (size_t)m * DM) + lane;
        f32x4* orow = (f32x4*)(out + (size_t)m * DM) + lane;
        f32x4 v[4]; float s = 0.f;
#pragma unroll
        for (int j = 0; j < 4; ++j) { const u32x2 t = xr[64 * j]; v[j] = (f32x4){bf_lo(t.x), bf_hi(t.x), bf_lo(t.y), bf_hi(t.y)}; s += (v[j][0] * v[j][0] + v[j][1] * v[j][1]) + (v[j][2] * v[j][2] + v[j][3] * v[j][3]); }
        const float rstd = rsqrtf(wave_sum(s) * (1.f / DM) + RMS_EPS);
#pragma unroll
        for (int j = 0; j < 4; ++j) orow[64 * j] = v[j] * rstd * wv[j];
    }
}

namespace att {
constexpr int PLD = 3072, KROWB = 272, VROWB = 136;
constexpr int SLOT = 64 * KROWB + 128 * VROWB;
constexpr int OFF_STAT = 2 * SLOT, OFF_X = OFF_STAT + 256;

template <int MODE>
__device__ __forceinline__ void unit(const bf16_t* P, bf16_t* AO, int b, int h, int qb, lptr sm, float lam, const float* subln, float lam_init) {
    const int tid = opaque_tid(), lane = tid & 63, wid = __builtin_amdgcn_readfirstlane(tid >> 6), r32 = lane & 31, hi = lane >> 5;
    constexpr int UROWS = MODE ? 256 : 128;
    const int comp = MODE ? 0 : (wid >> 2);
    const int q0 = qb * UROWS, tq0 = q0 + 32 * (MODE ? wid : (wid & 3)), tq = tq0 + r32;
    const size_t rowbase = (size_t)b * SEQ;
    const int qcol = MODE ? 1536 + h * 128 : h * 128 + 64 * comp;
    const int kcol = MODE ? 2048 + h * 128 : 512 + h * 128;
    const int vcol = MODE ? 2560 + h * 128 : 1024 + h * 128;
    constexpr int NJ = MODE ? 8 : 4;
    bf16x8 qf[NJ];
#pragma unroll
    for (int j = 0; j < NJ; ++j) qf[j] = *(const bf16x8*)(P + (rowbase + tq) * PLD + qcol + 16 * j + 8 * hi);
    const int nt = (q0 + UROWS) / 64;
    const int kt_d = tq0 >> 6, dsub = (tq0 >> 5) & 1;
    const int krow0 = tid >> 4, kseg = tid & 15;
    const int vo = 4 * (wid & 3) + (lane & 3), vp = 16 * (wid >> 2) + (lane >> 2);
    u32x4 kA0, kA1, vA0, vA1, kB0, kB1, vB0, vB1;
    const bf16_t* const kp0_ = P + (rowbase + krow0) * PLD + kcol + kseg * 8;
    const bf16_t* const vp0_ = P + (rowbase + 2 * vp) * PLD + vcol + 8 * vo;
#define ATT_LOAD(kt, K0, K1, V0, V1) do { const size_t to_ = (size_t)(kt) * (64 * PLD); \
        K0 = *(const u32x4*)(kp0_ + to_); K1 = *(const u32x4*)(kp0_ + to_ + 32 * PLD); \
        V0 = *(const u32x4*)(vp0_ + to_); V1 = *(const u32x4*)(vp0_ + to_ + PLD); } while (0)
#define ATT_STORE(slot, K0, K1, V0, V1) do { const lptr sb_ = sm + (slot) * SLOT; \
        *(LAS u32x4*)(sb_ + krow0 * KROWB + kseg * 16) = K0; *(LAS u32x4*)(sb_ + (krow0 + 32) * KROWB + kseg * 16) = K1; \
        _Pragma("unroll") for (int i = 0; i < 8; ++i) { \
            const unsigned w_ = __builtin_amdgcn_perm(V1[i >> 1], V0[i >> 1], (i & 1) ? 0x07060302u : 0x05040100u);     \
            *(LAS unsigned*)(sb_ + 64 * KROWB + (8 * vo + i) * VROWB + 4 * vp) = w_; } } while (0)
    LAS int* stat = (LAS int*)(sm + OFF_STAT);
    __syncthreads();
    if (tid < 16) stat[tid] = 0;
    if (MODE == 0) {
        ATT_LOAD(nt - 1, kB0, kB1, vB0, vB1);
        ATT_STORE(1, kB0, kB1, vB0, vB1);
        ATT_LOAD(nt - 2, kA0, kA1, vA0, vA1);
        ATT_LOAD(nt >= 4 ? nt - 3 : 0, kB0, kB1, vB0, vB1);
    } else {
        ATT_LOAD(nt - 1, kA0, kA1, vA0, vA1);
        ATT_STORE(1, kA0, kA1, vA0, vA1);
        ATT_LOAD(nt - 2, kA0, kA1, vA0, vA1);
    }
    f32x16 O[4];
#pragma unroll
    for (int i = 0; i < 4; ++i)
#pragma unroll
        for (int r = 0; r < 16; ++r) O[i][r] = 0.f;
    float mrun = -1e30f, lrun = 0.f, Crun = 0.f;
    bool wdone = false;
    const float slope2 = fast_exp2(-2.0f * (float)(h + 1)) * LOG2E;
    const float c1 = (MODE ? 0.08838834764831845f : 0.125f) * LOG2E;
    const float slc = slope2 / c1;
    if (wid >= 4) __builtin_amdgcn_s_setprio(1);
    bool stop = false;
#define ATT_HEAD(kt, K0, K1, V0, V1) \
        BAR_LDS();                            \
        int doneall = 0; \
        if (MODE) { const LAS int* st = stat + 8 * (((kt) + 1) & 1); doneall = (st[0] + st[1]) + (st[2] + st[3]) + (st[4] + st[5]) + (st[6] + st[7]); } \
        if (MODE == 0) { ATT_STORE(((kt) - 1) & 1, K0, K1, V0, V1); ATT_LOAD((kt) > 3 ? (kt) - 3 : 0, K0, K1, V0, V1); }     \
        else if ((kt) > 0) { ATT_STORE(((kt) - 1) & 1, K0, K1, V0, V1); if ((kt) > 1) ATT_LOAD((kt) - 2, K0, K1, V0, V1); }
    for (int kt2 = nt - 1; kt2 >= 0 && !stop; kt2 -= 2)
#pragma unroll
    for (int half = 0; half < 2; ++half) {
        const int kt = kt2 - half;
        if (stop) continue;
        int doneall_;
        if (half == 0 || MODE == 1) { ATT_HEAD(kt, kA0, kA1, vA0, vA1) doneall_ = doneall; }
        else { ATT_HEAD(kt, kB0, kB1, vB0, vB1) doneall_ = doneall; }
        const int doneall = doneall_;
        if (MODE && doneall == 8) { stop = true; continue; }
        const lptr Ks = sm + (kt & 1) * SLOT, Vs = Ks + 64 * KROWB;
        if (kt <= kt_d && !wdone) {
        if (MODE == 0) {
            f32x16 s[2];
            const bool diag = (kt == kt_d);
            const float bias0 = diag ? 0.f : slc * (float)(kt * 64 + 4 * hi);
            const float slc0 = diag ? 0.f : slc;
#pragma unroll
            for (int sub = 0; sub < 2; ++sub) {
#pragma unroll
                for (int r = 0; r < 16; ++r) s[sub][r] = __builtin_fmaf(slc0, (float)(32 * sub + (r & 3) + 8 * (r >> 2)), bias0);
#pragma unroll
                for (int j = 0; j < 4; ++j) {
                    const bf16x8 kf = *(const LAS bf16x8*)(Ks + (32 * sub + r32) * KROWB + (64 * comp + 16 * j + 8 * hi) * 2);
                    s[sub] = MFMA32(kf, qf[j], s[sub]);
                }
            }
            if (diag) {
#pragma unroll
                for (int sub = 0; sub < 2; ++sub)
#pragma unroll
                    for (int r = 0; r < 16; ++r) {
                        const int kv = kt * 64 + 32 * sub + crow(r, hi);
                        s[sub][r] += slc * ((float)tq - fabsf((float)(tq - kv)));
                    }
            }
            float mx = -1e30f;
#pragma unroll
            for (int sub = 0; sub < 2; ++sub)
#pragma unroll
                for (int r = 0; r < 16; r += 2) mx = __builtin_fmaxf(__builtin_fmaxf(mx, s[sub][r]), s[sub][r + 1]);
            mx = x32_max(mx);
            if (!__all((mx - mrun) * c1 < -150.0f)) {
            const float mnew = fmaxf(mrun, mx);
            const float f = fast_exp2((mrun - mnew) * c1);
            mrun = mnew; lrun *= f;
            if (__any(f != 1.0f)) {
#pragma unroll
                for (int i = 0; i < 4; ++i) O[i] = O[i] * f;
            }
            const float mc = -mnew * c1;
            bf16x8 pf[2][2];
            float ls = 0.f;
#pragma unroll
            for (int sub = 0; sub < 2; ++sub) {
#pragma unroll
                for (int r = 0; r < 16; ++r) { const float pv = fast_exp2(__builtin_fmaf(s[sub][r], c1, mc)); s[sub][r] = pv; ls += pv; }
#pragma unroll
                for (int s2 = 0; s2 < 2; ++s2) {
                    u32x4 w; w.x = pk2(s[sub][8 * s2 + 0], s[sub][8 * s2 + 1]); w.y = pk2(s[sub][8 * s2 + 2], s[sub][8 * s2 + 3]);
                    w.z = pk2(s[sub][8 * s2 + 4], s[sub][8 * s2 + 5]); w.w = pk2(s[sub][8 * s2 + 6], s[sub][8 * s2 + 7]);
                    pf[sub][s2] = __builtin_bit_cast(bf16x8, w);
                }
            }
            lrun += ls;
            {
#define VFRAG(blk_, q_) ({ const lptr vb_ = Vs + (32 * (blk_) + r32) * VROWB + 2 * (16 * (q_) + 4 * hi); const s16x4 lo_ = *(const LAS s16x4*)vb_, hi_ = *(const LAS s16x4*)(vb_ + 16); (bf16x8)__builtin_shufflevector(lo_, hi_, 0, 1, 2, 3, 4, 5, 6, 7); })
                bf16x8 vcur[4], vnxt[4];
#pragma unroll
                for (int q = 0; q < 4; ++q) vcur[q] = VFRAG(0, q);
#pragma unroll
                for (int blk = 0; blk < 4; ++blk) {
                    if (blk < 3) {
#pragma unroll
                        for (int q = 0; q < 4; ++q) vnxt[q] = VFRAG(blk + 1, q);
                    }
#pragma unroll
                    for (int q = 0; q < 4; ++q) O[blk] = MFMA32(vcur[q], pf[q >> 1][q & 1], O[blk]);
#pragma unroll
                    for (int q = 0; q < 4; ++q) vcur[q] = vnxt[q];
                }
#undef VFRAG
            }
            }
        } else {
#pragma unroll
            for (int subi = 0; subi < 2; ++subi) {
                const int sub = 1 - subi;
                if (kt == kt_d && sub > dsub) continue;
                const bool diag = (kt == kt_d && sub == dsub);
                f32x16 s;
#pragma unroll
                for (int r = 0; r < 16; ++r) s[r] = 0.f;
#pragma unroll
                for (int j = 0; j < 8; ++j) {
                    const bf16x8 kf = *(const LAS bf16x8*)(Ks + (32 * sub + r32) * KROWB + (16 * j + 8 * hi) * 2);
                    s = MFMA32(kf, qf[j], s);
                }
                const int kvbase = kt * 64 + 32 * sub;
                float lk[16], yl[16];
#pragma unroll
                for (int r = 0; r < 16; ++r) {
                    const float y = s[r] * c1;
                    const float e = fast_exp2(-fabsf(y));
                    const float L = fmaxf(y, 0.f) + fast_log2(1.0f + e);
                    const bool valid = !diag || (kvbase + crow(r, hi) < tq);
                    lk[r] = valid ? -L : 0.f;
                    yl[r] = valid ? (y - L) : -1e30f;
                }
                float gs[4], pgs[4];
#pragma unroll
                for (int g = 0; g < 4; ++g) { gs[g] = (lk[4 * g] + lk[4 * g + 1]) + (lk[4 * g + 2] + lk[4 * g + 3]); pgs[g] = x32_other(gs[g], hi); }
                const float T0 = gs[0] + pgs[0], T1 = gs[1] + pgs[1], T2 = gs[2] + pgs[2], T3 = gs[3] + pgs[3];
                float Sg[4]; Sg[3] = 0.f; Sg[2] = T3; Sg[1] = T3 + T2; Sg[0] = T3 + T2 + T1;
                float a[16];
#pragma unroll
                for (int g = 0; g < 4; ++g) {
                    float c = Crun + Sg[g] + (hi == 0 ? pgs[g] : 0.f);
                    a[4 * g + 3] = fast_exp2(yl[4 * g + 3] + c); c += lk[4 * g + 3];
                    a[4 * g + 2] = fast_exp2(yl[4 * g + 2] + c); c += lk[4 * g + 2];
                    a[4 * g + 1] = fast_exp2(yl[4 * g + 1] + c); c += lk[4 * g + 1];
                    a[4 * g + 0] = fast_exp2(yl[4 * g + 0] + c);
                }
                Crun += Sg[0] + T0;
                bf16x8 pf[2];
#pragma unroll
                for (int s2 = 0; s2 < 2; ++s2) {
                    u32x4 w; w.x = pk2(a[8 * s2 + 0], a[8 * s2 + 1]); w.y = pk2(a[8 * s2 + 2], a[8 * s2 + 3]);
                    w.z = pk2(a[8 * s2 + 4], a[8 * s2 + 5]); w.w = pk2(a[8 * s2 + 6], a[8 * s2 + 7]);
                    pf[s2] = __builtin_bit_cast(bf16x8, w);
                }
                {
#define VFRAG(blk_, s2_) ({ const lptr vb_ = Vs + (32 * (blk_) + r32) * VROWB + 2 * (32 * sub + 16 * (s2_) + 4 * hi); const s16x4 lo_ = *(const LAS s16x4*)vb_, hi_ = *(const LAS s16x4*)(vb_ + 16); (bf16x8)__builtin_shufflevector(lo_, hi_, 0, 1, 2, 3, 4, 5, 6, 7); })
                    bf16x8 vcur[2], vnxt[2];
                    vcur[0] = VFRAG(0, 0); vcur[1] = VFRAG(0, 1);
#pragma unroll
                    for (int blk = 0; blk < 4; ++blk) {
                        if (blk < 3) { vnxt[0] = VFRAG(blk + 1, 0); vnxt[1] = VFRAG(blk + 1, 1); }
                        O[blk] = MFMA32(vcur[0], pf[0], O[blk]); O[blk] = MFMA32(vcur[1], pf[1], O[blk]);
                        vcur[0] = vnxt[0]; vcur[1] = vnxt[1];
                    }
#undef VFRAG
                }
            }
            if (__all(Crun < -160.0f)) wdone = true;
        }
        }
        if (MODE) { if (lane == 0) stat[8 * (kt & 1) + wid] = wdone ? 1 : 0; }
    }
#undef ATT_STORE
#undef ATT_HEAD
    __builtin_amdgcn_s_setprio(0);
#undef ATT_LOAD
    if (MODE == 1) {
        bf16_t* orow = AO + (rowbase + tq) * DM + 512 + h * 128;
#pragma unroll
        for (int blk = 0; blk < 4; ++blk)
#pragma unroll
            for (int g = 0; g < 4; ++g) {
                u32x2 w; w.x = pk2(O[blk][4 * g], O[blk][4 * g + 1]); w.y = pk2(O[blk][4 * g + 2], O[blk][4 * g + 3]);
                *(u32x2*)(orow + 32 * blk + 8 * g + 4 * hi) = w;
            }
    } else {
        const float ltot = x32_sum(lrun);
        const float inv = 1.0f / ltot;
        LAS float* X = (LAS float*)(sm + OFF_X);
        if (wid >= 4) {
#pragma unroll
            for (int blk = 0; blk < 4; ++blk)
#pragma unroll
                for (int r = 0; r < 16; ++r) X[(((wid - 4) * 64 + blk * 16 + r) << 6) + lane] = O[blk][r] * inv;
        }
        __syncthreads();
        if (wid < 4) {
            float ss = 0.f;
#pragma unroll
            for (int blk = 0; blk < 4; ++blk)
#pragma unroll
                for (int r = 0; r < 16; ++r) { const float o = O[blk][r] * inv - lam * X[((wid * 64 + blk * 16 + r) << 6) + lane]; O[blk][r] = o; ss += o * o; }
            ss = x32_sum(ss);
            const float rs = rsqrtf(ss * (1.0f / 128.0f) + RMS_EPS) * (1.0f - lam_init);
            bf16_t* orow = AO + (rowbase + tq) * DM + h * 128;
#pragma unroll
            for (int blk = 0; blk < 4; ++blk)
#pragma unroll
                for (int g = 0; g < 4; ++g) {
                    const int dv = 32 * blk + 8 * g + 4 * hi;
                    const f32x4 wv = *(const f32x4*)(subln + dv);
                    u32x2 w; w.x = pk2(O[blk][4 * g] * rs * wv[0], O[blk][4 * g + 1] * rs * wv[1]); w.y = pk2(O[blk][4 * g + 2] * rs * wv[2], O[blk][4 * g + 3] * rs * wv[3]);
                    *(u32x2*)(orow + dv) = w;
                }
        }
    }
}

__device__ __forceinline__ void phase(const bf16_t* P, bf16_t* AO, const float* lamp, const float* subln, int layer, unsigned* ctr, lptr sm) {
    asm volatile("" : "+s"(layer));
    const float lam_init = 0.8f - 0.6f * expf(-0.3f * (float)layer);
    float d1 = 0.f, d2 = 0.f;
    for (int i = 0; i < 64; ++i) { d1 += lamp[i] * lamp[64 + i]; d2 += lamp[128 + i] * lamp[192 + i]; }
    const float lam = expf(d1) - expf(d2) + lam_init;
    LAS int* nxt = (LAS int*)(sm + OFF_STAT + 128);
    for (;;) {
        __syncthreads();
        if (threadIdx.x == 0) nxt[0] = (int)__hip_atomic_fetch_add(ctr, 1u, __ATOMIC_RELAXED, __HIP_MEMORY_SCOPE_AGENT);
        __syncthreads();
        const int u = nxt[0];
        if (u >= 768) break;
        if (u < 512) {
            const int hh = 3 - (u >> 7), v = u & 127;
            unit<0>(P, AO, v & 3, hh, 31 - (v >> 2), sm, lam, subln, lam_init);
        } else {
            const int w = u - 512, bh = w & 15;
            unit<1>(P, AO, bh >> 2, bh & 3, 15 - (w >> 4), sm, lam, subln, lam_init);
        }
    }
}
}

namespace gdn {
constexpr int PLD = 4096;
constexpr int RB = 272, TB = 144;
constexpr int OFF_QS = 0, OFF_KS = 64 * RB, OFF_KBT = OFF_KS + 64 * RB, OFF_VBT = OFF_KBT + 128 * TB, OFF_LF = OFF_VBT + 128 * TB, OFF_TF = OFF_LF + 64 * 65 * 4,
              OFF_MF = OFF_TF + 64 * 68 * 4, OFF_TBF = OFF_MF + 16 * 68 * 4, OFF_GC = OFF_TBF + 64 * TB, OFF_BETA = OFF_GC + 256, OFF_END = OFF_BETA + 256;
static_assert(OFF_END <= 131072, "gdn LDS");

__device__ __forceinline__ void chunk_phase(const bf16_t* P, const float* ABv, const float* convw, const float* alog, const float* dtb, unsigned char* ws, lptr sm) {
    const int tid = opaque_tid(), lane = tid & 63, wid = __builtin_amdgcn_readfirstlane(tid >> 6), r32 = lane & 31, hi = lane >> 5;
    LAS float* gcs = (LAS float*)(sm + OFF_GC); LAS float* betas = (LAS float*)(sm + OFF_BETA);
    LAS float* Lf = (LAS float*)(sm + OFF_LF); LAS float* Tf = (LAS float*)(sm + OFF_TF); LAS float* Mf = (LAS float*)(sm + OFF_MF);
    const int part = tid >> 7, o = tid & 15, tg = (tid & 127) >> 4;
    u32x4 xr[11]; float braw = 0.f, araw = 0.f;
#define CHUNK_PREFETCH(unx) do { const int n_ = (unx) & 63, h_ = ((unx) >> 6) & 7, b_ = (unx) >> 9; \
        if (part < 3) { const int ch_ = part * 1024 + h_ * 128 + 8 * o; \
            _Pragma("unroll") for (int rr = 0; rr < 11; ++rr) { const int sp = n_ * 64 + 8 * tg + rr - 3; \
                if (sp >= 0) xr[rr] = *(const u32x4*)(P + ((size_t)b_ * SEQ + sp) * PLD + ch_); else xr[rr] = (u32x4){0u, 0u, 0u, 0u}; } \
            } \
        if (tid < 64) { const size_t t_ = (size_t)b_ * SEQ + (size_t)n_ * 64 + tid; braw = ABv[t_ * 16 + h_]; araw = ABv[t_ * 16 + 8 + h_]; } } while (0)
    if ((int)blockIdx.x < 2048) CHUNK_PREFETCH((int)blockIdx.x);
#pragma nounroll
    for (int un = blockIdx.x; un < 2048; un += gridDim.x) {
    int tid_l = tid; asm volatile("" : "+v"(tid_l));
    const int tid = tid_l, lane = tid & 63, wid = __builtin_amdgcn_readfirstlane(tid >> 6), r32 = lane & 31, hi = lane >> 5;
    const int part = tid >> 7, o = tid & 15, tg = (tid & 127) >> 4;
    const int n = un & 63, h = (un >> 6) & 7, b = un >> 9;
    const size_t tok0 = (size_t)b * SEQ + (size_t)n * 64;
    f32x4 wq[8];
    if (part < 3) { const int ch = part * 1024 + h * 128 + 8 * o;
#pragma unroll
        for (int k = 0; k < 4; ++k) { wq[2 * k] = *(const f32x4*)(convw + (size_t)k * 3072 + ch); wq[2 * k + 1] = *(const f32x4*)(convw + (size_t)k * 3072 + ch + 4); } }
    BAR_LDS();
    if (tid < 64) {
        const float beta = 1.0f / (1.0f + expf(-braw));
        const float xx = araw + dtb[h];
        const float sp = fmaxf(xx, 0.f) + log1pf(expf(-fabsf(xx)));
        float g = -expf(alog[h]) * sp;
#pragma unroll
        for (int o2 = 1; o2 < 64; o2 <<= 1) { const float t = __shfl_up(g, o2); if (lane >= o2) g += t; }
        gcs[tid] = g; betas[tid] = beta;
    }
    for (int i = tid; i < 64 * 68; i += 512) Tf[i] = 0.f;
    BAR_LDS();
    const float gl = gcs[63];
    {
        if (part < 3) {
            float y[8][8];
#pragma unroll
            for (int i = 0; i < 8; ++i) {
#pragma unroll
                for (int c = 0; c < 8; ++c) {
                    float acc = 0.f;
#pragma unroll
                    for (int k = 0; k < 4; ++k) { const unsigned u = xr[i + k][c >> 1]; acc += wq[2 * k + (c >> 2)][c & 3] * ((c & 1) ? bf_hi(u) : bf_lo(u)); }
                    y[i][c] = silu_f(acc);
                }
            }
            if (part < 2) {
#pragma unroll
                for (int i = 0; i < 8; ++i) {
                    float ss = 0.f;
#pragma unroll
                    for (int c = 0; c < 8; ++c) ss += y[i][c] * y[i][c];
                    ss = row16_sum(ss);
                    const float rn = rsqrtf(ss + 1e-6f) * (part == 0 ? 0.08838834764831845f : 1.0f);
#pragma unroll
                    for (int c = 0; c < 8; ++c) y[i][c] *= rn;
                }
            }
            if (part == 0) {
                bf16_t* QD = (bf16_t*)(ws + WS_QD) + (size_t)un * 8192;
#pragma unroll
                for (int i = 0; i < 8; ++i) {
                    const int tk = 8 * tg + i; const float eg = fexp(gcs[tk]);
                    u32x4 w; w.x = pk2(y[i][0], y[i][1]); w.y = pk2(y[i][2], y[i][3]); w.z = pk2(y[i][4], y[i][5]); w.w = pk2(y[i][6], y[i][7]);
                    *(LAS u32x4*)(sm + OFF_QS + tk * RB + 16 * o) = w;
                    u32x4 d; d.x = pk2(y[i][0] * eg, y[i][1] * eg); d.y = pk2(y[i][2] * eg, y[i][3] * eg); d.z = pk2(y[i][4] * eg, y[i][5] * eg); d.w = pk2(y[i][6] * eg, y[i][7] * eg);
                    *(u32x4*)(QD + (((((tk >> 5) * 8 + (o >> 1)) * 64) + (tk & 31) + 32 * (o & 1)) << 3)) = d;
                }
            } else if (part == 1) {
                bf16_t* KDT = (bf16_t*)(ws + WS_KDT) + (size_t)un * 8192;
                float f1[8], f2[8];
#pragma unroll
                for (int i = 0; i < 8; ++i) { const int tk = 8 * tg + i; const float gi = gcs[tk]; f1[i] = betas[tk] * fexp(gi); f2[i] = fexp(gl - gi);
                    u32x4 w; w.x = pk2(y[i][0], y[i][1]); w.y = pk2(y[i][2], y[i][3]); w.z = pk2(y[i][4], y[i][5]); w.w = pk2(y[i][6], y[i][7]);
                    *(LAS u32x4*)(sm + OFF_KS + tk * RB + 16 * o) = w; }
#pragma unroll
                for (int c = 0; c < 8; ++c) {
                    u32x4 w; w.x = pk2(y[0][c] * f1[0], y[1][c] * f1[1]); w.y = pk2(y[2][c] * f1[2], y[3][c] * f1[3]); w.z = pk2(y[4][c] * f1[4], y[5][c] * f1[5]); w.w = pk2(y[6][c] * f1[6], y[7][c] * f1[7]);
                    *(LAS u32x4*)(sm + OFF_KBT + (8 * o + c) * TB + 16 * tg) = w;
                    u32x4 d; d.x = pk2(y[0][c] * f2[0], y[1][c] * f2[1]); d.y = pk2(y[2][c] * f2[2], y[3][c] * f2[3]); d.z = pk2(y[4][c] * f2[4], y[5][c] * f2[5]); d.w = pk2(y[6][c] * f2[6], y[7][c] * f2[7]);
                    { const int dk = 8 * o + c; *(u32x4*)(KDT + (((((dk >> 5) * 4 + (tg >> 1)) * 64) + (dk & 31) + 32 * (tg & 1)) << 3)) = d; }
                }
            } else {
                float f1[8];
#pragma unroll
                for (int i = 0; i < 8; ++i) f1[i] = betas[8 * tg + i];
#pragma unroll
                for (int c = 0; c < 8; ++c) {
                    u32x4 w; w.x = pk2(y[0][c] * f1[0], y[1][c] * f1[1]); w.y = pk2(y[2][c] * f1[2], y[3][c] * f1[3]); w.z = pk2(y[4][c] * f1[4], y[5][c] * f1[5]); w.w = pk2(y[6][c] * f1[6], y[7][c] * f1[7]);
                    *(LAS u32x4*)(sm + OFF_VBT + (8 * o + c) * TB + 16 * tg) = w;
                }
            }
        }
    }
    __syncthreads();
    { const int nu = un + (int)gridDim.x; if (nu < 2048) CHUNK_PREFETCH(nu); }
    {
        const int mat = wid >> 2, bi = (wid & 3) >> 1, bj = wid & 1;
        f32x16 s;
#pragma unroll
        for (int r = 0; r < 16; ++r) s[r] = 0.f;
#pragma unroll
        for (int j = 0; j < 8; ++j) {
            const bf16x8 af = *(const LAS bf16x8*)(sm + (mat ? OFF_QS : OFF_KS) + (32 * bi + r32) * RB + (16 * j + 8 * hi) * 2);
            const bf16x8 bf = *(const LAS bf16x8*)(sm + OFF_KS + (32 * bj + r32) * RB + (16 * j + 8 * hi) * 2);
            s = MFMA32(af, bf, s);
        }
        const int jj = 32 * bj + r32; const float gj = gcs[jj];
        bf16_t* AQK = (bf16_t*)(ws + WS_AQK) + (size_t)un * 4096;
#pragma unroll
        for (int r = 0; r < 16; ++r) {
            const int ii = 32 * bi + crow(r, hi);
            const float dec = fexp(fminf(gcs[ii] - gj, 0.f));
            if (mat == 0) Lf[ii * 65 + jj] = (ii > jj) ? betas[ii] * s[r] * dec : 0.f;
            else AQK[((((ii >> 5) * 4 + (jj >> 4)) * 64 + (ii & 31) + 32 * ((jj >> 3) & 1)) << 3) + (jj & 7)] = (bf16_t)(pk2((ii >= jj) ? s[r] * dec : 0.f, 0.f) & 0xffffu);
        }
    }
    __syncthreads();
    if (tid < 64) {
        const int I = tid >> 4, c = tid & 15;
        float x[16];
#pragma unroll
        for (int i = 0; i < 16; ++i) {
            float v = (i == c) ? 1.f : 0.f;
#pragma unroll
            for (int j = 0; j < i; ++j) v -= Lf[(16 * I + i) * 65 + 16 * I + j] * x[j];
            x[i] = v;
        }
#pragma unroll
        for (int i = 0; i < 16; ++i) Tf[(16 * I + i) * 68 + 16 * I + c] = x[i];
    }
    __syncthreads();
#pragma nounroll
    for (int I = 1; I < 4; ++I) {
        const int ng = 4 * I;
        if (tid < 16 * ng) {
            const int i = tid / ng, c4 = (tid % ng) * 4;
            f32x4 acc = {0.f, 0.f, 0.f, 0.f};
            const LAS float* lrow = Lf + (16 * I + i) * 65;
#pragma unroll 8
            for (int k = 0; k < 16 * I; ++k) acc += *(const LAS f32x4*)(Tf + k * 68 + c4) * lrow[k];
            *(LAS f32x4*)(Mf + i * 68 + c4) = acc;
        }
        __syncthreads();
        if (tid < 16 * ng) {
            const int i = tid / ng, c4 = (tid % ng) * 4;
            f32x4 acc = {0.f, 0.f, 0.f, 0.f};
            const LAS float* drow = Tf + (16 * I + i) * 68 + 16 * I;
#pragma unroll
            for (int k = 0; k < 16; ++k) acc += *(const LAS f32x4*)(Mf + k * 68 + c4) * drow[k];
            *(LAS f32x4*)(Tf + (16 * I + i) * 68 + c4) = -acc;
        }
        __syncthreads();
    }
    for (int e = tid; e < 64 * 32; e += 512) {
        const int i = e >> 5, j2 = (e & 31) * 2;
        *(LAS unsigned*)(sm + OFF_TBF + i * TB + j2 * 2) = pk2(Tf[i * 68 + j2], Tf[i * 68 + j2 + 1]);
    }
    __syncthreads();
    {
        const int mat = wid >> 2, bi = (wid & 3) >> 1;
        float* U = (float*)(ws + WS_U);
        bf16_t* WG = (bf16_t*)(ws + WS_WG) + (size_t)un * 8192;
#pragma unroll
        for (int cc = 0; cc < 2; ++cc) {
            const int bc = 2 * (wid & 1) + cc;
            f32x16 s;
#pragma unroll
            for (int r = 0; r < 16; ++r) s[r] = 0.f;
#pragma unroll
            for (int k = 0; k < 4; ++k) {
                const bf16x8 af = *(const LAS bf16x8*)(sm + OFF_TBF + (32 * bi + r32) * TB + (16 * k + 8 * hi) * 2);
                const bf16x8 bf = *(const LAS bf16x8*)(sm + (mat ? OFF_KBT : OFF_VBT) + (32 * bc + r32) * TB + (16 * k + 8 * hi) * 2);
                s = MFMA32(af, bf, s);
            }
#pragma unroll
            for (int r = 0; r < 16; ++r) {
                const int ii = 32 * bi + crow(r, hi), c = 32 * bc + r32;
                if (mat == 0) U[(tok0 + ii) * DM + h * 128 + c] = s[r];
                else WG[((((ii >> 5) * 8 + (c >> 4)) * 64 + (ii & 31) + 32 * ((c >> 3) & 1)) << 3) + (c & 7)] = (bf16_t)(pk2(s[r], 0.f) & 0xffffu);
            }
        }
    }
    if (tid == 0) ((float*)(ws + WS_CD))[un] = expf(gcs[63]);
    }
#undef CHUNK_PREFETCH
}

constexpr int OFF_ST = 0, OFF_VN = 32 * RB;
__device__ __forceinline__ void scan_task(int task, unsigned char* ws, bf16_t* OB, lptr sm) {
    const int tid = opaque_tid(), lane = tid & 63, wid = __builtin_amdgcn_readfirstlane(tid >> 6), r32 = lane & 31, hi = lane >> 5;
    const int bh = task >> 2, sl = task & 3, b = bh >> 3, h = bh & 7, e0 = 32 * sl;
    const int role = wid < 2 ? 0 : (wid < 4 ? 1 : 2);
    const int rb = wid < 2 ? wid : (wid < 4 ? wid - 2 : wid - 4);
    const bf16_t* WG = (const bf16_t*)(ws + WS_WG); const bf16_t* QD = (const bf16_t*)(ws + WS_QD); const bf16_t* KDT = (const bf16_t*)(ws + WS_KDT);
    const bf16_t* AQK = (const bf16_t*)(ws + WS_AQK); float* U = (float*)(ws + WS_U); const float* CD = (const float*)(ws + WS_CD);
    __syncthreads();
    for (int i = tid; i < (32 * RB + 32 * TB) / 4; i += 512) ((LAS unsigned*)sm)[i] = 0u;
    f32x16 Sacc;
#pragma unroll
    for (int r = 0; r < 16; ++r) Sacc[r] = 0.f;
    bf16x8 faA[8], faB[8], faC[8]; u32x4 fxA[4], fxB[4], fxC[4];
    const size_t ubase = ((size_t)b * SEQ + 32 * rb + 4 * hi) * DM + h * 128 + e0 + r32;
    const size_t abase = (size_t)bh * 64 * 8192 + ((size_t)rb * 512 + lane) * 8;
    const size_t kbase = (size_t)bh * 64 * 8192 + ((size_t)rb * 256 + lane) * 8;
    const size_t qbase = (size_t)bh * 64 * 4096 + ((size_t)rb * 256 + lane) * 8;
#define NCL(nn) ((nn) < 63 ? (nn) : 63)
#define LOAD_R0(nn, FA, FX) do { const int n_ = NCL(nn); \
        _Pragma("unroll") for (int j = 0; j < 8; ++j) FA[j] = *(const bf16x8*)(WG + abase + (size_t)n_ * 8192 + 512 * j); \
        _Pragma("unroll") for (int r = 0; r < 16; ++r) FX[r >> 2][r & 3] = __float_as_uint(U[ubase + (size_t)(n_ * 64 + (r & 3) + 8 * (r >> 2)) * DM]); } while (0)
#define LOAD_R1(nn, FA, FX) do { const int n_ = NCL(nn); \
        _Pragma("unroll") for (int j = 0; j < 8; ++j) FA[j] = *(const bf16x8*)(QD + abase + (size_t)n_ * 8192 + 512 * j); \
        _Pragma("unroll") for (int j = 0; j < 4; ++j) FX[j] = *(const u32x4*)(AQK + qbase + (size_t)n_ * 4096 + 512 * j); } while (0)
#define LOAD_R2(nn, FA, FX) do { const int n_ = NCL(nn); \
        _Pragma("unroll") for (int j = 0; j < 4; ++j) FA[j] = *(const bf16x8*)(KDT + kbase + (size_t)n_ * 8192 + 512 * j); FX[0][0] = __float_as_uint(CD[(size_t)bh * 64 + n_]); } while (0)
#define STEP_R0(nn, FA, FX, LFA, LFX) do { LOAD_R0((nn) + 2, LFA, LFX); \
        f32x16 acc; _Pragma("unroll") for (int r = 0; r < 16; ++r) acc[r] = 0.f; \
        _Pragma("unroll") for (int j = 0; j < 8; ++j) { const bf16x8 sb = *(const LAS bf16x8*)(sm + OFF_ST + r32 * RB + (16 * j + 8 * hi) * 2); acc = MFMA32(FA[j], sb, acc); } \
        _Pragma("unroll") for (int g = 0; g < 4; ++g) { \
            u32x2 w; w.x = pk2(__uint_as_float(FX[g][0]) - acc[4 * g], __uint_as_float(FX[g][1]) - acc[4 * g + 1]); w.y = pk2(__uint_as_float(FX[g][2]) - acc[4 * g + 2], __uint_as_float(FX[g][3]) - acc[4 * g + 3]); \
            *(LAS u32x2*)(sm + OFF_VN + r32 * TB + 2 * (32 * rb + 8 * g + 4 * hi)) = w; } \
        BAR_LDS(); BAR_LDS(); } while (0)
#define STEP_R1(nn, FA, FX, LFA, LFX) do { LOAD_R1((nn) + 2, LFA, LFX); \
        f32x16 acc; _Pragma("unroll") for (int r = 0; r < 16; ++r) acc[r] = 0.f; \
        _Pragma("unroll") for (int j = 0; j < 8; ++j) { const bf16x8 sb = *(const LAS bf16x8*)(sm + OFF_ST + r32 * RB + (16 * j + 8 * hi) * 2); acc = MFMA32(FA[j], sb, acc); } \
        BAR_LDS(); \
        _Pragma("unroll") for (int k = 0; k < 4; ++k) { const bf16x8 vb = *(const LAS bf16x8*)(sm + OFF_VN + r32 * TB + (16 * k + 8 * hi) * 2); acc = MFMA32(__builtin_bit_cast(bf16x8, FX[k]), vb, acc); } \
        _Pragma("unroll") for (int r = 0; r < 16; r += 2) { const unsigned w_ = pk2(acc[r], acc[r + 1]); OB[ubase + (size_t)((nn) * 64 + (r & 3) + 8 * (r >> 2)) * DM] = (bf16_t)(w_ & 0xffffu); OB[ubase + (size_t)((nn) * 64 + ((r + 1) & 3) + 8 * ((r + 1) >> 2)) * DM] = (bf16_t)(w_ >> 16); } \
        BAR_LDS(); } while (0)
#define STEP_R2(nn, FA, FX, LFA, LFX) do { LOAD_R2((nn) + 2, LFA, LFX); \
        BAR_LDS(); \
        Sacc = Sacc * __uint_as_float(FX[0][0]); \
        _Pragma("unroll") for (int k = 0; k < 4; ++k) { const bf16x8 vb = *(const LAS bf16x8*)(sm + OFF_VN + r32 * TB + (16 * k + 8 * hi) * 2); Sacc = MFMA32(FA[k], vb, Sacc); } \
        _Pragma("unroll") for (int g = 0; g < 4; ++g) { u32x2 w; w.x = pk2(Sacc[4 * g], Sacc[4 * g + 1]); w.y = pk2(Sacc[4 * g + 2], Sacc[4 * g + 3]); \
            *(LAS u32x2*)(sm + OFF_ST + r32 * RB + 2 * (32 * rb + 8 * g + 4 * hi)) = w; } \
        BAR_LDS(); } while (0)
#define ROLE_LOOP(LOADM, STEPM) do { LOADM(0, faA, fxA); LOADM(1, faB, fxB); BAR_LDS(); \
        _Pragma("nounroll") for (int n = 0; n < 64; n += 3) { STEPM(n, faA, fxA, faC, fxC); if (n + 1 < 64) { STEPM(n + 1, faB, fxB, faA, fxA); STEPM(n + 2, faC, fxC, faB, fxB); } } } while (0)
    if (role == 0) ROLE_LOOP(LOAD_R0, STEP_R0);
    else if (role == 1) ROLE_LOOP(LOAD_R1, STEP_R1);
    else ROLE_LOOP(LOAD_R2, STEP_R2);
#undef NCL
#undef LOAD_R0
#undef LOAD_R1
#undef LOAD_R2
#undef STEP_R0
#undef STEP_R1
#undef STEP_R2
#undef ROLE_LOOP
}

__device__ __forceinline__ void post_phase(const bf16_t* O, const bf16_t* P, const float* nw, bf16_t* H) {
    const int tid = opaque_tid(), lane = tid & 63, wave = tid >> 6;
    const int gw = blockIdx.x * 8 + wave, NGW = gridDim.x * 8;
    const f32x4 wv = *(const f32x4*)(nw + ((4 * lane) & 127));
    for (int m = gw; m < M; m += NGW) {
        const u32x2* orow = (const u32x2*)(O + (size_t)m * DM) + lane;
        const u32x2* grow = (const u32x2*)(P + (size_t)m * PLD + 3072) + lane;
        u32x2* hrow = (u32x2*)(H + (size_t)m * DM) + lane;
#pragma unroll
        for (int j = 0; j < 4; ++j) {
            const u32x2 ov = orow[64 * j]; const f32x4 v = {bf_lo(ov.x), bf_hi(ov.x), bf_lo(ov.y), bf_hi(ov.y)}; const u32x2 gq = grow[64 * j];
            float ss = (v[0] * v[0] + v[1] * v[1]) + (v[2] * v[2] + v[3] * v[3]);
            ss = x16_sum(row16_sum(ss));
            const float rs = rsqrtf(ss * (1.0f / 128.0f) + RMS_EPS);
            u32x2 o; o.x = pk2(v[0] * rs * wv[0] * silu_f(bf_lo(gq.x)), v[1] * rs * wv[1] * silu_f(bf_hi(gq.x)));
            o.y = pk2(v[2] * rs * wv[2] * silu_f(bf_lo(gq.y)), v[3] * rs * wv[3] * silu_f(bf_hi(gq.y)));
            hrow[64 * j] = o;
        }
    }
}
}


#define GAS __attribute__((address_space(1)))
#define XB_TMO      32
#define XB_XCNT(j)  (64   + 32 * (j))
#define XB_XSUB(j)  (576  + 32 * (j))
#define XB_XGEN(j)  (1088 + 32 * (j))
#define XB_TOP      1600
#define XB_TOPGEN   1632
#define XCD_BAR_WORDS 1664
#define XB_SPIN_CAP (1u << 18)

__device__ __forceinline__ unsigned xb_ld(unsigned* p)              { return __hip_atomic_load(p, __ATOMIC_RELAXED, __HIP_MEMORY_SCOPE_AGENT); }
__device__ __forceinline__ unsigned xb_add(unsigned* p, unsigned v) { return __hip_atomic_fetch_add(p, v, __ATOMIC_RELAXED, __HIP_MEMORY_SCOPE_AGENT); }
__device__ __forceinline__ unsigned xb_xcc_id() { return (unsigned)__builtin_amdgcn_s_getreg((3 << 11) | 20) & 0xFu; }
#define XB_SPIN(cond, bar) do { unsigned _sp = 0; while (cond) { __builtin_amdgcn_s_sleep(1); \
    if ((++_sp & 255u) == 0u) { if (xb_ld(&(bar)[XB_TMO])) break; if (_sp > XB_SPIN_CAP) { atomicAdd(&(bar)[XB_TMO], 1u); break; } } } } while (0)

struct XcdBarrier {
    unsigned* bar; unsigned x;
    volatile LAS unsigned* st;
};

__device__ __forceinline__ XcdBarrier xcd_barrier_post(unsigned* bar, volatile LAS unsigned* st) {
    XcdBarrier b; b.bar = bar; b.x = xb_xcc_id(); b.st = st;
    if (threadIdx.x == 0) (void)xb_add(&bar[XB_XCNT(b.x)], 1u);
    return b;
}
__device__ __forceinline__ void xcd_barrier_complete(unsigned* bar, unsigned x, unsigned& nloc, unsigned& nx) {
    const unsigned G = gridDim.x * gridDim.y * gridDim.z;
    unsigned sum, cnt, mine, sp = 0u;
    for (;;) {
        sum = 0u; cnt = 0u; mine = 0u;
#pragma unroll
        for (unsigned j = 0; j < 16; ++j) { const unsigned c = xb_ld(&bar[XB_XCNT(j)]); sum += c; cnt += (c > 0u) ? 1u : 0u; mine = (j == x) ? c : mine; }
        if (sum == G) break;
        __builtin_amdgcn_s_sleep(1);
        if ((++sp & 255u) == 0u) { if (xb_ld(&bar[XB_TMO])) break; if (sp > XB_SPIN_CAP) { atomicAdd(&bar[XB_TMO], 1u); break; } }
    }
    nloc = mine > 0u ? mine : 1u; nx = cnt > 0u ? cnt : 1u;
}

__device__ __forceinline__ void xcd_barrier(const XcdBarrier& b) {
    asm volatile("s_waitcnt vmcnt(0)" ::: "memory");
    __syncthreads();
    if (threadIdx.x == 0) {
        unsigned* bar = b.bar;
        __builtin_amdgcn_s_waitcnt(0);
        unsigned nloc = b.st[0], nx = b.st[1];
        if (nloc == 0u) { xcd_barrier_complete(bar, b.x, nloc, nx); b.st[0] = nloc; b.st[1] = nx; }
        const unsigned old = xb_add(&bar[XB_XSUB(b.x)], 1u);
        const unsigned gen = old / nloc;
        if (old + 1u == (gen + 1u) * nloc) {
            __builtin_amdgcn_fence(__ATOMIC_RELEASE, "agent");
            asm volatile("s_waitcnt vmcnt(0)" ::: "memory");
            const unsigned og = xb_add(&bar[XB_TOP], 1u);
            const unsigned tg = og / nx;
            if (og + 1u == (tg + 1u) * nx) xb_add(&bar[XB_TOPGEN], 1u);
            else XB_SPIN(xb_ld(&bar[XB_TOPGEN]) == tg, bar);
            __builtin_amdgcn_fence(__ATOMIC_ACQUIRE, "agent");
            xb_add(&bar[XB_XGEN(b.x)], 1u);
            asm volatile("s_waitcnt vmcnt(0)" ::: "memory");
        } else {
            XB_SPIN(xb_ld(&bar[XB_XGEN(b.x)]) == gen, bar);
            __builtin_amdgcn_fence(__ATOMIC_ACQUIRE, "agent");
            asm volatile("s_waitcnt vmcnt(0)" ::: "memory");
        }
    }
    __syncthreads();
}
#ifndef PM
#define PM 0xFFFF
#endif
#define GSYNC() do { xcd_barrier(xbar); if (PROBE & 0x1000) xcd_barrier(xbar); } while (0)
__global__ void __launch_bounds__(512, 2) fwd_megakernel(Params p) {
    cg::grid_group grid = cg::this_grid();
    grid.sync();
    const lptr lds = (lptr)lds_raw;
    volatile LAS unsigned* xst = (volatile LAS unsigned*)(lds + 139264);
    if (threadIdx.x == 0) { xst[0] = 0u; xst[1] = 0u; }
    __syncthreads();
    XcdBarrier xbar = xcd_barrier_post((unsigned*)(p.ws + WS_BAR), xst);
    unsigned char* ws = p.ws;
    bf16_t* H = (bf16_t*)p.out;
    bf16_t* XB = (bf16_t*)(ws + WS_H);
    bf16_t* PROJ = (bf16_t*)(ws + WS_R1);
    bf16_t* HID = (bf16_t*)(ws + WS_HID);
    float* ABv = (float*)(ws + WS_AB);
    float* SS = (float*)(ws + WS_SS);
#pragma nounroll
    for (int l = 0; l < 4; ++l) {
        const bool odd = l & 1; const int e = l >> 1;
#pragma nounroll
        for (int sbk = 0; sbk < 3; ++sbk) {
            const int ni = 3 * l + sbk;
            if (sbk != 1) {
                if (sbk == 0 && l == 0) {
                    convert_layer(p, 0, lds, 1, 0); __syncthreads();
                    prologue_phase(p.in[0], XB, SS);
                    GSYNC();
                }
                for (int rp = 0; rp < REPS(4); ++rp) { EpiSwiGLU E{HID, DFF, SS + (size_t)(ni & 1) * M * 16}; run_gemm(lds, XB, (const bf16_t*)(ws + (sbk == 0 ? WS_WGU1 : WS_WGU2)), 2 * DFF, DM, E); }
                if ((int)blockIdx.x >= (int)gridDim.x / 2) {
                    if (sbk == 0) convert_layer(p, l, lds, 2, (int)gridDim.x / 2);
                    else if (l < 3) convert_layer(p, l + 1, lds, 1, (int)gridDim.x / 2);
                }
                GSYNC();
                { EpiResid<true> E{XB, SS + (size_t)((ni + 1) & 1) * M * 16}; run_gemm(lds, HID, (const bf16_t*)(ws + (sbk == 0 ? WS_WD1 : WS_WD2)), DM, DFF, E); }
                GSYNC();
            } else {
                const float* nw = p.in[5] + (size_t)l * DM;
                if (odd) ab_phase(XB, nw, SS + (size_t)(ni & 1) * M * 16, p.in[10] + (size_t)e * DM * 4112 + 4096, ABv, lds);
                for (int rp = 0; rp < REPS(4); ++rp) { const int nin = odd ? 4096 : 3072; EpiBf16 E{PROJ, nin, SS + (size_t)(ni & 1) * M * 16}; run_gemm(lds, XB, (const bf16_t*)(ws + WS_WIN), nin, DM, E); }
                GSYNC();
                if (!odd) {
                    att::phase(PROJ, H, p.in[7] + (size_t)e * 256, p.in[8] + (size_t)e * 128, l, (unsigned*)(ws + WS_BAR + 14336) + 64 * e, lds);
                } else {
                    gdn::chunk_phase(PROJ, ABv, p.in[11] + (size_t)e * 4 * 3072, p.in[12] + e * 8, p.in[13] + e * 8, ws, lds);
                    GSYNC();
                    for (int rp = 0; rp < REPS(128); ++rp) for (int t = blockIdx.x; t < 128; t += gridDim.x) gdn::scan_task((((t & 7) * 4 + (t >> 5)) << 2) | ((t >> 3) & 3), ws, H, lds);
                    GSYNC();
                    gdn::post_phase(H, PROJ, p.in[14] + e * 128, H);
                }
                GSYNC();
                { EpiResid<false> E{XB, SS + (size_t)((ni + 1) & 1) * M * 16}; run_gemm(lds, H, (const bf16_t*)(ws + WS_WOUT), DM, DM, E); }
                GSYNC();
            }
        }
    }
    final_norm_phase(XB, p.out, p.in[20]);
}

extern "C" void kernel_launch(void* const* d_in, const int* in_sizes, int n_in, void* d_out, int out_size, void* d_ws, size_t ws_size, hipStream_t stream) {
    static int grid = 0;
    if (grid == 0) {
        if (n_in != 21 || out_size != M * DM || ws_size < WS_END) { fprintf(stderr, "kernel_launch: unexpected shapes (n_in %d out %d ws %zu, need %zu)\n", n_in, out_size, ws_size, (size_t)WS_END); grid = -1; return; }
        int dev = 0, cus = 0, per_cu = 0;
        hipGetDevice(&dev);
        hipDeviceGetAttribute(&cus, hipDeviceAttributeMultiprocessorCount, dev);
        if (hipFuncSetAttribute((const void*)fwd_megakernel, hipFuncAttributeMaxDynamicSharedMemorySize, LDS_BYTES) != hipSuccess) { fprintf(stderr, "kernel_launch: hipFuncSetAttribute failed\n"); grid = -1; return; }
        if (hipOccupancyMaxActiveBlocksPerMultiprocessor(&per_cu, (const void*)fwd_megakernel, 512, LDS_BYTES) != hipSuccess || per_cu < 1) { fprintf(stderr, "kernel_launch: occupancy query gave %d\n", per_cu); per_cu = 1; }
        (void)hipGetLastError();
        grid = cus * 1;
        if (grid > 256) grid = 256;
    }
    if (grid < 0) return;
    if (hipMemsetAsync((char*)d_ws + WS_BAR, 0, 16384, stream) != hipSuccess) { fprintf(stderr, "kernel_launch: memset failed\n"); return; }
    Params p{};
    for (int i = 0; i < 21; ++i) p.in[i] = (const float*)d_in[i];
    p.out = (float*)d_out; p.ws = (unsigned char*)d_ws;
    void* args[] = {&p};
    hipError_t e = hipLaunchCooperativeKernel((const void*)fwd_megakernel, dim3(grid), dim3(512), args, LDS_BYTES, stream);
    if (e != hipSuccess) fprintf(stderr, "cooperative launch failed: %s (grid %d)\n", hipGetErrorString(e), grid);
}
```

```cpp
#include <hip/hip_runtime.h>
#include <hip/hip_cooperative_groups.h>
#include <cstdio>
#include <cstdint>
namespace cg = cooperative_groups;
#ifndef PROBE
#define PROBE 0
#endif
#define REPS(bit) ((PROBE & (bit)) ? 2 : 1)
__device__ __forceinline__ int opaque_tid() { int t = (int)threadIdx.x; asm volatile("" : "+v"(t)); return t; }
namespace pg8 {
#define PG8_LAS __attribute__((address_space(3)))
typedef unsigned short bf16_t;
typedef short bf16x8 __attribute__((ext_vector_type(8)));
typedef float f32x4 __attribute__((ext_vector_type(4)));
typedef unsigned u32x4 __attribute__((ext_vector_type(4)));
constexpr int BM = 256, BK = 64, HALF = 128, HTB = HALF * BK * 2  , STAGE_BYTES = 8 * HTB, NXCD = 8, WGM = 8;

__host__ __device__ __forceinline__ int lds_byte(int r, int c) { const int st = (r >> 4) * 2 + (c >> 5), rr = r & 15, cc = c & 31, ob = rr * 64 + cc * 2; return st * 1024 + (ob ^ (((ob >> 9) & 1) << 5)); }
__host__ __device__ __forceinline__ void stage_rc(int b, int& R, int& C) { const int st = b / 1024, sb = b % 1024, swz = sb ^ (((sb >> 9) & 1) << 5); R = (st >> 1) * 16 + swz / 64; C = (st & 1) * 32 + (swz % 64) / 2; }
__host__ __device__ __forceinline__ int perm32(int rho) { const int n = rho >> 4, i = rho & 15; return 8 * (i >> 2) + 4 * n + (i & 3); }

struct Unit { int pm, pn; };
struct Gemm { const bf16_t* A; const bf16_t* Bt; int M, N, K; };

struct StaticOrder {
    int nM, nN, nwg, G, c;
    __host__ __device__ void init(int M, int N, int G_, int c_) { nM = M / BM; nN = N / BM; nwg = nM * nN; G = G_; c = c_; }
    __host__ __device__ bool next(int i, Unit& u) const {
        const long L = (long)i * G + c; if (L >= nwg) return false;
        int wgid = (int)L; { const int q = nwg / NXCD, r = nwg % NXCD, xcd = wgid % NXCD, off = wgid / NXCD; wgid = (xcd < r ? xcd * (q + 1) : r * (q + 1) + (xcd - r) * q) + off; }
        const int nig = WGM * nN, gid = wgid / nig, fm = gid * WGM, gsz = (nM - fm) < WGM ? (nM - fm) : WGM;
        u.pm = fm + ((wgid % nig) % gsz); u.pn = (wgid % nig) / gsz; return true;
    }
    __device__ __forceinline__ void a_ready(const Unit&) const {}
    __device__ __forceinline__ void done(const Unit&) const {}
};

template <class Epi, class Sched, bool ALIGN_EPI = false, bool SP2 = false>
__device__ __forceinline__ void gemm_phase(PG8_LAS unsigned char* lds, const Gemm g, const Sched& S, const Epi& E) {
    const int tid = opaque_tid(), wid = __builtin_amdgcn_readfirstlane(tid >> 6), lane = tid & 63, wr = wid >> 2, wc = wid & 3, fr = lane & 15, fq = lane >> 4;
    const int K = g.K, nt = K / BK;
    unsigned voffA[2], voffB[2];
#pragma unroll
    for (int i = 0; i < 2; ++i) { int R, C; stage_rc(tid * 16 + i * 8192, R, C); const int Rb = Epi::PERM ? ((R & ~31) + perm32(R & 31)) : R;
        voffA[i] = (unsigned)(R * K + C) * 2u; voffB[i] = (unsigned)(Rb * K + C) * 2u; }
    const size_t kstep = (size_t)(BK * 2);
    const size_t hstep = (size_t)HALF * K * 2;
    const size_t tstep = 2 * hstep;
    const unsigned ldsw = (unsigned)wid * 1024u;
    const int aoff = lds_byte(wr * 64 + fr, fq * 8), boff = lds_byte(wc * 32 + fr, fq * 8);
#define PG8_SA(b, h) (((b) * 2 + (h)) * HTB)
#define PG8_SB(b, h) ((4 + (b) * 2 + (h)) * HTB)
#define PG8_STAGE(bufoff, gbase, voff) do { _Pragma("unroll") for (int _i = 0; _i < 2; ++_i) \
        __builtin_amdgcn_global_load_lds((const unsigned*)((const char*)(gbase) + (voff)[_i]), (PG8_LAS unsigned*)(lds + (bufoff) + ldsw + _i * 8192), 16, 0, 0); } while (0)
#define PG8_LDA(dst, b, h) do { _Pragma("unroll") for (int m = 0; m < 4; ++m) _Pragma("unroll") for (int k = 0; k < 2; ++k) dst[m][k] = *(const PG8_LAS bf16x8*)(lds + PG8_SA(b, h) + aoff + m * 2048 + k * 1024); } while (0)
#define PG8_LDB(dst, b, h) do { _Pragma("unroll") for (int n = 0; n < 2; ++n) _Pragma("unroll") for (int k = 0; k < 2; ++k) dst[n][k] = *(const PG8_LAS bf16x8*)(lds + PG8_SB(b, h) + boff + n * 2048 + k * 1024); } while (0)
#define PG8_MMA(ai, bj, At, Bt) do { __builtin_amdgcn_s_setprio(1); _Pragma("unroll") for (int m = 0; m < 4; ++m) _Pragma("unroll") for (int n = 0; n < 2; ++n) _Pragma("unroll") for (int k = 0; k < 2; ++k) \
        acc[ai][bj][m][n] = __builtin_amdgcn_mfma_f32_16x16x32_bf16(Bt[n][k], At[m][k], acc[ai][bj][m][n], 0, 0, 0); __builtin_amdgcn_s_setprio(0); } while (0)
#define PG8_WAIT_V(n) asm volatile("s_waitcnt vmcnt(" #n ")" ::: "memory")
#define PG8_WAIT_L(n) asm volatile("s_waitcnt lgkmcnt(" #n ")" ::: "memory")
#define PG8_BAR __builtin_amdgcn_s_barrier()
#define PG8_SCHED __builtin_amdgcn_sched_barrier(0)
    Unit cur, nxt; int ui = 0;
    if (!S.next(0, cur)) return;
    f32x4 acc[2][2][4][2];
#pragma unroll
    for (int a = 0; a < 2; ++a)
#pragma unroll
        for (int b = 0; b < 2; ++b)
#pragma unroll
            for (int m = 0; m < 4; ++m)
#pragma unroll
                for (int n = 0; n < 2; ++n) acc[a][b][m][n] = (f32x4){0.f, 0.f, 0.f, 0.f};
    bf16x8 At[4][2], B0[2][2], B1[2][2];
    const char* cA = (const char*)g.A + (size_t)cur.pm * tstep; const char* cB = (const char*)g.Bt + (size_t)cur.pn * tstep;
    S.a_ready(cur);
    if constexpr (SP2) {
        PG8_STAGE(PG8_SB(0, 0), cB, voffB); PG8_STAGE(PG8_SB(0, 1), cB + hstep, voffB); PG8_STAGE(PG8_SA(0, 0), cA, voffA); PG8_STAGE(PG8_SA(0, 1), cA + hstep, voffA);
        if (wr == 1) PG8_BAR;
        PG8_WAIT_V(2); PG8_BAR;
        PG8_STAGE(PG8_SB(1, 0), cB + kstep, voffB); PG8_STAGE(PG8_SA(1, 0), cA + kstep, voffA); PG8_STAGE(PG8_SB(1, 1), cB + hstep + kstep, voffB);
        PG8_WAIT_V(6); PG8_BAR;
    } else {
        PG8_STAGE(PG8_SB(0, 0), cB, voffB); PG8_STAGE(PG8_SA(0, 0), cA, voffA); PG8_STAGE(PG8_SB(0, 1), cB + hstep, voffB); PG8_STAGE(PG8_SA(0, 1), cA + hstep, voffA);
        if (wr == 1) PG8_BAR;
        PG8_WAIT_V(4); PG8_BAR;
        PG8_STAGE(PG8_SB(1, 0), cB + kstep, voffB); PG8_STAGE(PG8_SA(1, 0), cA + kstep, voffA); PG8_STAGE(PG8_SB(1, 1), cB + hstep + kstep, voffB);
        PG8_WAIT_V(6); PG8_BAR;
    }
    for (;;) {
        const bool has_next = S.next(ui + 1, nxt);
        const char* nA = has_next ? (const char*)g.A + (size_t)nxt.pm * tstep : cA; const char* nB = has_next ? (const char*)g.Bt + (size_t)nxt.pn * tstep : cB;
        for (int t = 0; t < nt; t += 2) {
            const bool last = (t == nt - 2);
            const char* a1 = cA + (size_t)(t + 1) * kstep;
            const char* a2 = last ? nA : cA + (size_t)(t + 2) * kstep; const char* b2 = last ? nB : cB + (size_t)(t + 2) * kstep;
            const char* a3 = a2 + kstep; const char* b3 = b2 + kstep;
            if (last && has_next) S.a_ready(nxt);
            if constexpr (SP2) {
            PG8_LDB(B0, 0, 0); PG8_LDB(B1, 0, 1); PG8_SCHED; PG8_LDA(At, 0, 0); PG8_STAGE(PG8_SA(1, 1), a1 + hstep, voffA);
            PG8_WAIT_V(8); PG8_WAIT_L(0); PG8_BAR; PG8_MMA(0, 0, At, B0); PG8_MMA(0, 1, At, B1); PG8_BAR; PG8_SCHED;
            PG8_LDA(At, 0, 1); PG8_STAGE(PG8_SB(0, 0), b2, voffB); PG8_STAGE(PG8_SB(0, 1), b2 + hstep, voffB); PG8_STAGE(PG8_SA(0, 0), a2, voffA);
            PG8_WAIT_V(8); PG8_WAIT_L(0); PG8_BAR; PG8_MMA(1, 0, At, B0); PG8_MMA(1, 1, At, B1); PG8_BAR; PG8_SCHED;
            PG8_LDB(B0, 1, 0); PG8_LDB(B1, 1, 1); PG8_SCHED; PG8_LDA(At, 1, 0); PG8_STAGE(PG8_SA(0, 1), a2 + hstep, voffA);
            PG8_WAIT_V(8); PG8_WAIT_L(0); PG8_BAR; PG8_MMA(0, 0, At, B0); PG8_MMA(0, 1, At, B1); PG8_BAR; PG8_SCHED;
            PG8_LDA(At, 1, 1); PG8_STAGE(PG8_SB(1, 0), b3, voffB); PG8_STAGE(PG8_SB(1, 1), b3 + hstep, voffB); PG8_STAGE(PG8_SA(1, 0), a3, voffA);
            PG8_WAIT_V(8); PG8_WAIT_L(0); PG8_BAR; PG8_MMA(1, 0, At, B0); PG8_MMA(1, 1, At, B1); PG8_BAR; PG8_SCHED;
            } else {
            PG8_LDB(B0, 0, 0); PG8_SCHED; PG8_LDA(At, 0, 0); PG8_STAGE(PG8_SA(1, 1), a1 + hstep, voffA);
            PG8_WAIT_L(8); PG8_BAR; PG8_WAIT_L(0); PG8_MMA(0, 0, At, B0); PG8_BAR; PG8_SCHED;
            PG8_LDB(B1, 0, 1); PG8_STAGE(PG8_SB(0, 0), b2, voffB);
            PG8_BAR; PG8_WAIT_L(0); PG8_MMA(0, 1, At, B1); PG8_BAR;
            PG8_LDA(At, 0, 1); PG8_STAGE(PG8_SA(0, 0), a2, voffA);
            PG8_BAR; PG8_WAIT_L(0); PG8_MMA(1, 0, At, B0); PG8_BAR; PG8_SCHED;
            PG8_STAGE(PG8_SB(0, 1), b2 + hstep, voffB);
            PG8_WAIT_V(6); PG8_BAR; PG8_MMA(1, 1, At, B1); PG8_BAR;
            PG8_LDB(B0, 1, 0); PG8_SCHED; PG8_LDA(At, 1, 0); PG8_STAGE(PG8_SA(0, 1), a2 + hstep, voffA);
            PG8_WAIT_L(8); PG8_BAR; PG8_WAIT_L(0); PG8_MMA(0, 0, At, B0); PG8_BAR; PG8_SCHED;
            PG8_LDB(B1, 1, 1); PG8_STAGE(PG8_SB(1, 0), b3, voffB);
            PG8_BAR; PG8_WAIT_L(0); PG8_MMA(0, 1, At, B1); PG8_BAR;
            PG8_LDA(At, 1, 1); PG8_STAGE(PG8_SA(1, 0), a3, voffA);
            PG8_BAR; PG8_WAIT_L(0); PG8_MMA(1, 0, At, B0); PG8_BAR; PG8_SCHED;
            PG8_STAGE(PG8_SB(1, 1), b3 + hstep, voffB);
            PG8_WAIT_V(6); PG8_BAR; PG8_MMA(1, 1, At, B1); PG8_BAR;
            }
        }
        if constexpr (ALIGN_EPI) { if (wr == 0) PG8_BAR; }
        if constexpr (!Epi::AFTER_DRAIN) { E(acc, cur, wr, wc, fr, fq); S.done(cur); }
        if (!has_next) break;
#pragma unroll
        for (int a = 0; a < 2; ++a)
#pragma unroll
            for (int b = 0; b < 2; ++b)
#pragma unroll
                for (int m = 0; m < 4; ++m)
#pragma unroll
                    for (int n = 0; n < 2; ++n) acc[a][b][m][n] = (f32x4){0.f, 0.f, 0.f, 0.f};
        cur = nxt; cA = nA; cB = nB; ++ui;
        if constexpr (ALIGN_EPI) { if (wr == 1) PG8_BAR; }
    }
    PG8_WAIT_V(0);
    if constexpr (!ALIGN_EPI) { if (wr == 0) PG8_BAR; }
    PG8_BAR;
    if constexpr (Epi::AFTER_DRAIN) { E.fused(acc, cur, wr, wc, fr, fq, lds, wid, lane); S.done(cur); }
#undef PG8_SA
#undef PG8_SB
#undef PG8_STAGE
#undef PG8_LDA
#undef PG8_LDB
#undef PG8_MMA
#undef PG8_WAIT_V
#undef PG8_WAIT_L
#undef PG8_BAR
#undef PG8_SCHED
}
}

#define LAS __attribute__((address_space(3)))
typedef unsigned short bf16_t;
typedef short bf16x8 __attribute__((ext_vector_type(8)));
typedef short s16x4 __attribute__((ext_vector_type(4)));
typedef float f32x4 __attribute__((ext_vector_type(4)));
typedef float f32x16 __attribute__((ext_vector_type(16)));
typedef unsigned u32x4 __attribute__((ext_vector_type(4)));
typedef unsigned u32x2 __attribute__((ext_vector_type(2)));
typedef float f32x2_t __attribute__((ext_vector_type(2)));
typedef __bf16 bf16x2_t __attribute__((ext_vector_type(2)));
typedef LAS unsigned char* lptr;
#define BAR_LDS() asm volatile("s_waitcnt lgkmcnt(0)\n\ts_barrier" ::: "memory")
#define MFMA32(a, b, c) __builtin_amdgcn_mfma_f32_32x32x16_bf16((a), (b), (c), 0, 0, 0)

constexpr int BATCH = 4, SEQ = 4096, DM = 1024, DFF = 2816, M = BATCH * SEQ;
constexpr float RMS_EPS = 1e-6f, LOG2E = 1.4426950408889634f;
constexpr size_t MiB = 1u << 20;
constexpr size_t WS_WGU1 = 0, WS_WD1 = 11534336, WS_WIN = 17301504, WS_WOUT = 25690112, WS_WGU2 = 27787264, WS_WD2 = 39321600;
constexpr size_t WS_H = 48 * MiB, WS_AB = 80 * MiB, WS_CD = 81 * MiB, WS_BAR = 81 * MiB + 512 * 1024, WS_R1 = 82 * MiB, WS_R2 = 210 * MiB;
constexpr size_t WS_HID = WS_R2, WS_WG = WS_R2, WS_QD = WS_R2 + 32 * MiB, WS_KDT = WS_R2 + 64 * MiB, WS_AQK = WS_R2 + 96 * MiB, WS_U = WS_R2 + 112 * MiB, WS_END = WS_R2 + 176 * MiB;
constexpr size_t WS_XB = WS_R2 + 96 * MiB;
constexpr size_t WS_SS = 44 * MiB;
constexpr int LDS_BYTES = 147456;

__device__ __forceinline__ unsigned pk2(float lo, float hi) { f32x2_t v = {lo, hi}; bf16x2_t b = __builtin_convertvector(v, bf16x2_t); return __builtin_bit_cast(unsigned, b); }
__device__ __forceinline__ float bf_lo(unsigned u) { return __uint_as_float(u << 16); }
__device__ __forceinline__ float bf_hi(unsigned u) { return __uint_as_float(u & 0xffff0000u); }
template <int CTRL> __device__ __forceinline__ float dpp_f(float v) { return __uint_as_float((unsigned)__builtin_amdgcn_update_dpp(0, (int)__float_as_uint(v), CTRL, 0xf, 0xf, false)); }
__device__ __forceinline__ float row16_sum(float v) { v += dpp_f<0x128>(v); v += dpp_f<0x124>(v); v += dpp_f<0x122>(v); v += dpp_f<0x121>(v); return v; }
__device__ __forceinline__ float x16_sum(float v) { auto rr = __builtin_amdgcn_permlane16_swap(__float_as_uint(v), __float_as_uint(v), false, false); return __uint_as_float(rr[0]) + __uint_as_float(rr[1]); }
__device__ __forceinline__ float x32_sum(float v) { auto rr = __builtin_amdgcn_permlane32_swap(__float_as_uint(v), __float_as_uint(v), false, false); return __uint_as_float(rr[0]) + __uint_as_float(rr[1]); }
__device__ __forceinline__ float x32_max(float v) { auto rr = __builtin_amdgcn_permlane32_swap(__float_as_uint(v), __float_as_uint(v), false, false); return fmaxf(__uint_as_float(rr[0]), __uint_as_float(rr[1])); }
__device__ __forceinline__ float x32_other(float v, int hi) { auto rr = __builtin_amdgcn_permlane32_swap(__float_as_uint(v), __float_as_uint(v), false, false); return __uint_as_float(hi ? rr[0] : rr[1]); }
__device__ __forceinline__ float wave_sum(float v) { return x32_sum(x16_sum(row16_sum(v))); }
__device__ __forceinline__ int crow(int r, int hi) { return (r & 3) + 8 * (r >> 2) + 4 * hi; }
__device__ __forceinline__ float fast_exp2(float x) { return __builtin_amdgcn_exp2f(x); }
__device__ __forceinline__ float fast_log2(float x) { return __builtin_amdgcn_logf(x); }
__device__ __forceinline__ float fexp(float x) { return __builtin_amdgcn_exp2f(x * LOG2E); }
__device__ __forceinline__ float silu_f(float g) { return g * __builtin_amdgcn_rcpf(1.0f + __expf(-g)); }

__device__ __forceinline__ float row_rstd(const float* ss, int row) {
    const f32x4* q = (const f32x4*)(ss + (size_t)row * 16); const f32x4 a = q[0], b = q[1], c = q[2], d = q[3];
    const float t = ((a[0] + a[1]) + (a[2] + a[3])) + ((b[0] + b[1]) + (b[2] + b[3])) + ((c[0] + c[1]) + (c[2] + c[3])) + ((d[0] + d[1]) + (d[2] + d[3]));
    return rsqrtf(t * (1.f / DM) + RMS_EPS);
}
extern __shared__ __attribute__((aligned(16))) unsigned char lds_raw[];
constexpr int RS_TAB_OFF = 132096, RS_PM_OFF = 136192;
__device__ __forceinline__ const LAS float* rstd_table(const float* ss, int pm, int wr, int wc, int lane) {
    const lptr l0 = (lptr)lds_raw;
    const int wave = wr * 4 + wc;
    LAS float* tab = (LAS float*)(l0 + RS_TAB_OFF + wave * 512);
    LAS int* cpm = (LAS int*)(l0 + RS_PM_OFF + wave * 4);
    if (cpm[0] != pm) {
        tab[lane] = row_rstd(ss, pm * 256 + wr * 64 + lane);
        tab[64 + lane] = row_rstd(ss, pm * 256 + 128 + wr * 64 + lane);
        if (lane == 0) cpm[0] = pm;
        asm volatile("s_waitcnt lgkmcnt(0)" ::: "memory");
    }
    return tab;
}
struct EpiSwiGLU {
    static constexpr bool PERM = true, AFTER_DRAIN = false;
    bf16_t* O; int ldc; const float* ss;
    __device__ __forceinline__ void operator()(const pg8::f32x4 (&acc)[2][2][4][2], const pg8::Unit& u, int wr, int wc, int fr, int fq) const {
        const int row0 = u.pm * 256 + wr * 64 + fr, col0 = u.pn * 128 + wc * 32 + 8 * fq;
        const LAS float* tab = rstd_table(ss, u.pm, wr, wc, fr + 16 * fq);
#pragma unroll
        for (int ai = 0; ai < 2; ++ai)
#pragma unroll
            for (int m = 0; m < 4; ++m) {
                const int row = row0 + ai * 128 + m * 16;
                const float rs = tab[64 * ai + 16 * m + fr];
                bf16_t* rowp = O + (size_t)row * ldc + col0;
                const pg8::f32x4 g0 = acc[ai][0][m][0] * rs, g1 = acc[ai][0][m][1] * rs, u0 = acc[ai][1][m][0] * rs, u1 = acc[ai][1][m][1] * rs;
                u32x4 w;
                w.x = pk2(silu_f(g0[0]) * u0[0], silu_f(g0[1]) * u0[1]); w.y = pk2(silu_f(g0[2]) * u0[2], silu_f(g0[3]) * u0[3]);
                w.z = pk2(silu_f(g1[0]) * u1[0], silu_f(g1[1]) * u1[1]); w.w = pk2(silu_f(g1[2]) * u1[2], silu_f(g1[3]) * u1[3]);
                *(u32x4*)rowp = w;
            }
    }
};
template <bool HALF> struct EpiResid {
    static constexpr bool PERM = true, AFTER_DRAIN = false;
    static constexpr float s = HALF ? 0.5f : 1.0f;
    bf16_t* xb; float* ssn;
    __device__ __forceinline__ void operator()(const pg8::f32x4 (&acc)[2][2][4][2], const pg8::Unit& u, int wr, int wc, int fr, int fq) const {
        const int row0 = u.pm * 256 + wr * 64 + fr, col0 = u.pn * 256 + wc * 32 + 8 * fq;
#pragma unroll
        for (int ai = 0; ai < 2; ++ai)
#pragma unroll
            for (int m = 0; m < 4; ++m) {
                const int row = row0 + ai * 128 + m * 16;
                bf16_t* rowp = xb + (size_t)row * DM + col0;
                float q = 0.f;
#pragma unroll
                for (int bj = 0; bj < 2; ++bj) {
                    const u32x4 bb = *(const u32x4*)(rowp + bj * 128);
                    const pg8::f32x4 b0 = {bf_lo(bb.x), bf_hi(bb.x), bf_lo(bb.y), bf_hi(bb.y)}, b1 = {bf_lo(bb.z), bf_hi(bb.z), bf_lo(bb.w), bf_hi(bb.w)};
                    const pg8::f32x4 v0 = b0 + acc[ai][bj][m][0] * s, v1 = b1 + acc[ai][bj][m][1] * s;
                    u32x4 w; w.x = pk2(v0[0], v0[1]); w.y = pk2(v0[2], v0[3]); w.z = pk2(v1[0], v1[1]); w.w = pk2(v1[2], v1[3]);
                    *(u32x4*)(rowp + bj * 128) = w;
                    q += ((v0[0] * v0[0] + v0[1] * v0[1]) + (v0[2] * v0[2] + v0[3] * v0[3])) + ((v1[0] * v1[0] + v1[1] * v1[1]) + (v1[2] * v1[2] + v1[3] * v1[3]));
                }
                q = x32_sum(x16_sum(q));
                if (fq == 0) ssn[(size_t)row * 16 + u.pn * 4 + wc] = q;
            }
    }
};
struct EpiBf16 {
    static constexpr bool PERM = true, AFTER_DRAIN = false;
    bf16_t* O; int ldc; const float* ss;
    __device__ __forceinline__ void operator()(const pg8::f32x4 (&acc)[2][2][4][2], const pg8::Unit& u, int wr, int wc, int fr, int fq) const {
        const int row0 = u.pm * 256 + wr * 64 + fr, col0 = u.pn * 256 + wc * 32 + 8 * fq;
        const LAS float* tab = rstd_table(ss, u.pm, wr, wc, fr + 16 * fq);
#pragma unroll
        for (int ai = 0; ai < 2; ++ai)
#pragma unroll
            for (int m = 0; m < 4; ++m) {
                const int row = row0 + ai * 128 + m * 16;
                const float rs = tab[64 * ai + 16 * m + fr];
                bf16_t* rowp = O + (size_t)row * ldc + col0;
#pragma unroll
                for (int bj = 0; bj < 2; ++bj) {
                    const pg8::f32x4 v0 = acc[ai][bj][m][0] * rs, v1 = acc[ai][bj][m][1] * rs;
                    u32x4 w; w.x = pk2(v0[0], v0[1]); w.y = pk2(v0[2], v0[3]); w.z = pk2(v1[0], v1[1]); w.w = pk2(v1[2], v1[3]);
                    *(u32x4*)(rowp + bj * 128) = w;
                }
            }
    }
};
template <class Epi>
__device__ __forceinline__ void run_gemm(lptr lds, const bf16_t* A, const bf16_t* Bt, int N, int K, const Epi& E) {
    { const int t_ = opaque_tid(); if ((t_ & 63) == 0) *(LAS int*)(lds + RS_PM_OFF + (t_ >> 6) * 4) = -1; }
    pg8::Gemm g{A, Bt, M, N, K}; pg8::StaticOrder S; S.init(M, N, (int)gridDim.x, (int)blockIdx.x);
    pg8::gemm_phase<Epi, pg8::StaticOrder, true, true>(lds, g, S, E);
}

__device__ __forceinline__ void tr_item(const float* W, int ldw, int k0, int n0, bf16_t* WT, int K, int drow0, LAS float* scr, int lane, const float* nw) {
    float tv[32];
#pragma unroll
    for (int i = 0; i < 32; ++i) tv[i] = W[(size_t)(k0 + 2 * i + (lane >> 5)) * ldw + n0 + (lane & 31)];
#pragma unroll
    for (int i = 0; i < 32; ++i) scr[(2 * i + (lane >> 5)) * 33 + (lane & 31)] = nw ? tv[i] * nw[k0 + 2 * i + (lane >> 5)] : tv[i];
    asm volatile("s_waitcnt lgkmcnt(0)" ::: "memory");
    const int c = lane & 7;
#pragma unroll
    for (int j = 0; j < 4; ++j) {
        const int n = (lane >> 3) + 8 * j; const LAS float* s = scr + (8 * c) * 33 + n;
        u32x4 o; o.x = pk2(s[0 * 33], s[1 * 33]); o.y = pk2(s[2 * 33], s[3 * 33]); o.z = pk2(s[4 * 33], s[5 * 33]); o.w = pk2(s[6 * 33], s[7 * 33]);
        *(u32x4*)(WT + (size_t)(drow0 + n) * K + k0 + 8 * c) = o;
    }
    asm volatile("s_waitcnt lgkmcnt(0)" ::: "memory");
}
struct Params { const float* in[21]; float* out; unsigned char* ws; };

__device__ __forceinline__ void convert_layer(const Params& p, int l, lptr lds, int part, int b0) {
    const int tid = opaque_tid(), lane = tid & 63, wave = tid >> 6;
    LAS float* scr = (LAS float*)(lds + wave * 16384);
    const int gw = ((int)blockIdx.x - b0) * 8 + wave, NGW = ((int)gridDim.x - b0) * 8;
    const bool odd = l & 1; const int e = l >> 1;
    const float* Win = odd ? p.in[10] + (size_t)e * DM * 4112 : p.in[6] + (size_t)e * DM * 3072;
    const int ldin = odd ? 4112 : 3072, nin = odd ? 4096 : 3072;
    const float* Wout = odd ? p.in[15] + (size_t)e * DM * DM : p.in[9] + (size_t)e * DM * DM;
    const int I_G = (DM / 64) * (DFF / 32), I_D = (DFF / 64) * (DM / 32), I_IN = (DM / 64) * (nin / 32), I_OUT = (DM / 64) * (DM / 32);
    const int n1 = 2 * I_G + I_D, total = 4 * I_G + 2 * I_D + I_IN + I_OUT;
    for (int it = (part == 1 ? 0 : n1) + gw; it < (part == 1 ? n1 : total); it += NGW) {
        int r = it;
#define SEG(Wp, LDW, KK, NITEMS, NBLK, WTOFF, MODE, NW) \
        if (r < (NITEMS)) { const int kb = r / (NBLK), nb = r % (NBLK); const int n0 = 32 * nb; \
            const int dr = (MODE) == 0 ? n0 : ((n0 >> 7) * 256 + (n0 & 127) + ((MODE) == 2 ? 128 : 0)); \
            tr_item((Wp), (LDW), 64 * kb, n0, (bf16_t*)(p.ws + (WTOFF)), (KK), dr, scr, lane, (NW)); continue; } r -= (NITEMS);
        SEG(p.in[2] + (size_t)l * DM * DFF, DFF, DM, I_G, DFF / 32, WS_WGU1, 1, p.in[1] + (size_t)l * DM)
        SEG(p.in[3] + (size_t)l * DM * DFF, DFF, DM, I_G, DFF / 32, WS_WGU1, 2, p.in[1] + (size_t)l * DM)
        SEG(p.in[4] + (size_t)l * DM * DFF, DM, DFF, I_D, DM / 32, WS_WD1, 0, (const float*)nullptr)
        if (odd) { SEG(Win, 4112, DM, 2048, 128, WS_WIN, 0, p.in[5] + (size_t)l * DM) } else { SEG(Win, 3072, DM, 1536, 96, WS_WIN, 0, p.in[5] + (size_t)l * DM) }
        SEG(Wout, DM, DM, I_OUT, DM / 32, WS_WOUT, 0, (const float*)nullptr)
        SEG(p.in[17] + (size_t)l * DM * DFF, DFF, DM, I_G, DFF / 32, WS_WGU2, 1, p.in[16] + (size_t)l * DM)
        SEG(p.in[18] + (size_t)l * DM * DFF, DFF, DM, I_G, DFF / 32, WS_WGU2, 2, p.in[16] + (size_t)l * DM)
        SEG(p.in[19] + (size_t)l * DM * DFF, DM, DFF, I_D, DM / 32, WS_WD2, 0, (const float*)nullptr)
#undef SEG
    }
}

__device__ __forceinline__ void prologue_phase(const float* X, bf16_t* XB, float* ss) {
    const int tid = opaque_tid(), lane = tid & 63, wave = tid >> 6;
    const int gw = blockIdx.x * 8 + wave, NGW = gridDim.x * 8;
    for (int m = gw; m < M; m += NGW) {
        const f32x4* xr = (const f32x4*)(X + (size_t)m * DM) + lane;
        f32x4 v[4]; float s = 0.f;
#pragma unroll
        for (int j = 0; j < 4; ++j) { v[j] = xr[64 * j]; s += (v[j][0] * v[j][0] + v[j][1] * v[j][1]) + (v[j][2] * v[j][2] + v[j][3] * v[j][3]); }
        s = wave_sum(s);
        u32x2* o8 = (u32x2*)(XB + (size_t)m * DM) + lane;
#pragma unroll
        for (int j = 0; j < 4; ++j) { u32x2 o; o.x = pk2(v[j][0], v[j][1]); o.y = pk2(v[j][2], v[j][3]); o8[64 * j] = o; }
        if (lane < 16) ss[(size_t)m * 16 + lane] = lane == 0 ? s : 0.f;
    }
}
__device__ __forceinline__ void ab_phase(const bf16_t* XBp, const float* w, const float* ss, const float* W16src, float* ABout, lptr lds) {
    const int tid = opaque_tid(), lane = tid & 63, wave = tid >> 6;
    const int gw = blockIdx.x * 8 + wave, NGW = gridDim.x * 8;
    LAS float* W16t = (LAS float*)lds;
    for (int k = tid; k < DM; k += 512) {
        const f32x4* src = (const f32x4*)(W16src + (size_t)k * 4112);
#pragma unroll
        for (int q = 0; q < 4; ++q) { const f32x4 v = src[q]; W16t[(4 * q + 0) * 1024 + k] = v[0]; W16t[(4 * q + 1) * 1024 + k] = v[1]; W16t[(4 * q + 2) * 1024 + k] = v[2]; W16t[(4 * q + 3) * 1024 + k] = v[3]; }
    }
    __syncthreads();
    f32x4 wv[4];
#pragma unroll
    for (int j = 0; j < 4; ++j) wv[j] = ((const f32x4*)w)[64 * j + lane];
    for (int m = gw; m < M; m += NGW) {
        const u32x2* xr = (const u32x2*)(XBp + (size_t)m * DM) + lane;
        const float rstd = row_rstd(ss, m);
        f32x4 v[4];
#pragma unroll
        for (int j = 0; j < 4; ++j) { const u32x2 t = xr[64 * j]; const f32x4 xv = {bf_lo(t.x), bf_hi(t.x), bf_lo(t.y), bf_hi(t.y)}; v[j] = xv * rstd * wv[j]; }
        float mine = 0.f;
#pragma nounroll
        for (int c = 0; c < 16; ++c) {
            float a = 0.f;
#pragma unroll
            for (int j = 0; j < 4; ++j) { const f32x4 t = *(const LAS f32x4*)(W16t + c * 1024 + 256 * j + 4 * lane); a += (v[j][0] * t[0] + v[j][1] * t[1]) + (v[j][2] * t[2] + v[j][3] * t[3]); }
            a = wave_sum(a);
            if (lane == c) mine = a;
        }
        if (lane < 16) ABout[(size_t)m * 16 + lane] = mine;
    }
    __syncthreads();
}
__device__ __forceinline__ void final_norm_phase(const bf16_t* XBp, float* out, const float* w) {
    const int tid = opaque_tid(), lane = tid & 63, wave = tid >> 6;
    const int gw = blockIdx.x * 8 + wave, NGW = gridDim.x * 8;
    f32x4 wv[4];
#pragma unroll
    for (int j = 0; j < 4; ++j) wv[j] = ((const f32x4*)w)[64 * j + lane];
    for (int m = gw; m < M; m += NGW) {
        const u32x2* xr = (const u32x2*)(XBp + (size_t)m * DM) + lane;
        f32x4* orow = (f32x4*)(out + (size_t)m * DM) + lane;
        f32x4 v[4]; float s = 0.f;
#pragma unroll
        for (int j = 0; j < 4; ++j) { const u32x2 t = xr[64 * j]; v[j] = (f32x4){bf_lo(t.x), bf_hi(t.x), bf_lo(t.y), bf_hi(t.y)}; s += (v[j][0] * v[j][0] + v[j][1] * v[j][1]) + (v[j][2] * v[j][2] + v[j][3] * v[j][3]); }
        const float rstd = rsqrtf(wave_sum(s) * (1.f / DM) + RMS_EPS);
#pragma unroll
        for (int j = 0; j < 4; ++j) orow[64 * j] = v[j] * rstd * wv[j];
    }
}

namespace att {
constexpr int PLD = 3072, KROWB = 272, VROWB = 136;
constexpr int SLOT = 64 * KROWB + 128 * VROWB;
constexpr int OFF_STAT = 2 * SLOT, OFF_X = OFF_STAT + 256;

template <int MODE>
__device__ __forceinline__ void unit(const bf16_t* P, bf16_t* AO, int b, int h, int qb, lptr sm, float lam, const float* subln, float lam_init) {
    const int tid = opaque_tid(), lane = tid & 63, wid = __builtin_amdgcn_readfirstlane(tid >> 6), r32 = lane & 31, hi = lane >> 5;
    constexpr int UROWS = MODE ? 256 : 128;
    const int comp = MODE ? 0 : (wid >> 2);
    const int q0 = qb * UROWS, tq0 = q0 + 32 * (MODE ? wid : (wid & 3)), tq = tq0 + r32;
    const size_t rowbase = (size_t)b * SEQ;
    const int qcol = MODE ? 1536 + h * 128 : h * 128 + 64 * comp;
    const int kcol = MODE ? 2048 + h * 128 : 512 + h * 128;
    const int vcol = MODE ? 2560 + h * 128 : 1024 + h * 128;
    constexpr int NJ = MODE ? 8 : 4;
    bf16x8 qf[NJ];
#pragma unroll
    for (int j = 0; j < NJ; ++j) qf[j] = *(const bf16x8*)(P + (rowbase + tq) * PLD + qcol + 16 * j + 8 * hi);
    const int nt = (q0 + UROWS) / 64;
    const int kt_d = tq0 >> 6, dsub = (tq0 >> 5) & 1;
    const int krow0 = tid >> 4, kseg = tid & 15;
    const int vo = 4 * (wid & 3) + (lane & 3), vp = 16 * (wid >> 2) + (lane >> 2);
    u32x4 kA0, kA1, vA0, vA1, kB0, kB1, vB0, vB1;
    const bf16_t* const kp0_ = P + (rowbase + krow0) * PLD + kcol + kseg * 8;
    const bf16_t* const vp0_ = P + (rowbase + 2 * vp) * PLD + vcol + 8 * vo;
#define ATT_LOAD(kt, K0, K1, V0, V1) do { const size_t to_ = (size_t)(kt) * (64 * PLD); \
        K0 = *(const u32x4*)(kp0_ + to_); K1 = *(const u32x4*)(kp0_ + to_ + 32 * PLD); \
        V0 = *(const u32x4*)(vp0_ + to_); V1 = *(const u32x4*)(vp0_ + to_ + PLD); } while (0)
#define ATT_STORE(slot, K0, K1, V0, V1) do { const lptr sb_ = sm + (slot) * SLOT; \
        *(LAS u32x4*)(sb_ + krow0 * KROWB + kseg * 16) = K0; *(LAS u32x4*)(sb_ + (krow0 + 32) * KROWB + kseg * 16) = K1; \
        _Pragma("unroll") for (int i = 0; i < 8; ++i) { \
            const unsigned w_ = __builtin_amdgcn_perm(V1[i >> 1], V0[i >> 1], (i & 1) ? 0x07060302u : 0x05040100u);     \
            *(LAS unsigned*)(sb_ + 64 * KROWB + (8 * vo + i) * VROWB + 4 * vp) = w_; } } while (0)
    LAS int* stat = (LAS int*)(sm + OFF_STAT);
    __syncthreads();
    if (tid < 16) stat[tid] = 0;
    if (MODE == 0) {
        ATT_LOAD(nt - 1, kB0, kB1, vB0, vB1);
        ATT_STORE(1, kB0, kB1, vB0, vB1);
        ATT_LOAD(nt - 2, kA0, kA1, vA0, vA1);
        ATT_LOAD(nt >= 4 ? nt - 3 : 0, kB0, kB1, vB0, vB1);
    } else {
        ATT_LOAD(nt - 1, kA0, kA1, vA0, vA1);
        ATT_STORE(1, kA0, kA1, vA0, vA1);
        ATT_LOAD(nt - 2, kA0, kA1, vA0, vA1);
    }
    f32x16 O[4];
#pragma unroll
    for (int i = 0; i < 4; ++i)
#pragma unroll
        for (int r = 0; r < 16; ++r) O[i][r] = 0.f;
    float mrun = -1e30f, lrun = 0.f, Crun = 0.f;
    bool wdone = false;
    const float slope2 = fast_exp2(-2.0f * (float)(h + 1)) * LOG2E;
    const float c1 = (MODE ? 0.08838834764831845f : 0.125f) * LOG2E;
    const float slc = slope2 / c1;
    if (wid >= 4) __builtin_amdgcn_s_setprio(1);
    bool stop = false;
#define ATT_HEAD(kt, K0, K1, V0, V1) \
        BAR_LDS();                            \
        int doneall = 0; \
        if (MODE) { const LAS int* st = stat + 8 * (((kt) + 1) & 1); doneall = (st[0] + st[1]) + (st[2] + st[3]) + (st[4] + st[5]) + (st[6] + st[7]); } \
        if (MODE == 0) { ATT_STORE(((kt) - 1) & 1, K0, K1, V0, V1); ATT_LOAD((kt) > 3 ? (kt) - 3 : 0, K0, K1, V0, V1); }     \
        else if ((kt) > 0) { ATT_STORE(((kt) - 1) & 1, K0, K1, V0, V1); if ((kt) > 1) ATT_LOAD((kt) - 2, K0, K1, V0, V1); }
    for (int kt2 = nt - 1; kt2 >= 0 && !stop; kt2 -= 2)
#pragma unroll
    for (int half = 0; half < 2; ++half) {
        const int kt = kt2 - half;
        if (stop) continue;
        int doneall_;
        if (half == 0 || MODE == 1) { ATT_HEAD(kt, kA0, kA1, vA0, vA1) doneall_ = doneall; }
        else { ATT_HEAD(kt, kB0, kB1, vB0, vB1) doneall_ = doneall; }
        const int doneall = doneall_;
        if (MODE && doneall == 8) { stop = true; continue; }
        const lptr Ks = sm + (kt & 1) * SLOT, Vs = Ks + 64 * KROWB;
        if (kt <= kt_d && !wdone) {
        if (MODE == 0) {
            f32x16 s[2];
            const bool diag = (kt == kt_d);
            const float bias0 = diag ? 0.f : slc * (float)(kt * 64 + 4 * hi);
            const float slc0 = diag ? 0.f : slc;
#pragma unroll
            for (int sub = 0; sub < 2; ++sub) {
#pragma unroll
                for (int r = 0; r < 16; ++r) s[sub][r] = __builtin_fmaf(slc0, (float)(32 * sub + (r & 3) + 8 * (r >> 2)), bias0);
#pragma unroll
                for (int j = 0; j < 4; ++j) {
                    const bf16x8 kf = *(const LAS bf16x8*)(Ks + (32 * sub + r32) * KROWB + (64 * comp + 16 * j + 8 * hi) * 2);
                    s[sub] = MFMA32(kf, qf[j], s[sub]);
                }
            }
            if (diag) {
#pragma unroll
                for (int sub = 0; sub < 2; ++sub)
#pragma unroll
                    for (int r = 0; r < 16; ++r) {
                        const int kv = kt * 64 + 32 * sub + crow(r, hi);
                        s[sub][r] += slc * ((float)tq - fabsf((float)(tq - kv)));
                    }
            }
            float mx = -1e30f;
#pragma unroll
            for (int sub = 0; sub < 2; ++sub)
#pragma unroll
                for (int r = 0; r < 16; r += 2) mx = __builtin_fmaxf(__builtin_fmaxf(mx, s[sub][r]), s[sub][r + 1]);
            mx = x32_max(mx);
            if (!__all((mx - mrun) * c1 < -150.0f)) {
            const float mnew = fmaxf(mrun, mx);
            const float f = fast_exp2((mrun - mnew) * c1);
            mrun = mnew; lrun *= f;
            if (__any(f != 1.0f)) {
#pragma unroll
                for (int i = 0; i < 4; ++i) O[i] = O[i] * f;
            }
            const float mc = -mnew * c1;
            bf16x8 pf[2][2];
            float ls = 0.f;
#pragma unroll
            for (int sub = 0; sub < 2; ++sub) {
#pragma unroll
                for (int r = 0; r < 16; ++r) { const float pv = fast_exp2(__builtin_fmaf(s[sub][r], c1, mc)); s[sub][r] = pv; ls += pv; }
#pragma unroll
                for (int s2 = 0; s2 < 2; ++s2) {
                    u32x4 w; w.x = pk2(s[sub][8 * s2 + 0], s[sub][8 * s2 + 1]); w.y = pk2(s[sub][8 * s2 + 2], s[sub][8 * s2 + 3]);
                    w.z = pk2(s[sub][8 * s2 + 4], s[sub][8 * s2 + 5]); w.w = pk2(s[sub][8 * s2 + 6], s[sub][8 * s2 + 7]);
                    pf[sub][s2] = __builtin_bit_cast(bf16x8, w);
                }
            }
            lrun += ls;
            {
#define VFRAG(blk_, q_) ({ const lptr vb_ = Vs + (32 * (blk_) + r32) * VROWB + 2 * (16 * (q_) + 4 * hi); const s16x4 lo_ = *(const LAS s16x4*)vb_, hi_ = *(const LAS s16x4*)(vb_ + 16); (bf16x8)__builtin_shufflevector(lo_, hi_, 0, 1, 2, 3, 4, 5, 6, 7); })
                bf16x8 vcur[4], vnxt[4];
#pragma unroll
                for (int q = 0; q < 4; ++q) vcur[q] = VFRAG(0, q);
#pragma unroll
                for (int blk = 0; blk < 4; ++blk) {
                    if (blk < 3) {
#pragma unroll
                        for (int q = 0; q < 4; ++q) vnxt[q] = VFRAG(blk + 1, q);
                    }
#pragma unroll
                    for (int q = 0; q < 4; ++q) O[blk] = MFMA32(vcur[q], pf[q >> 1][q & 1], O[blk]);
#pragma unroll
                    for (int q = 0; q < 4; ++q) vcur[q] = vnxt[q];
                }
#undef VFRAG
            }
            }
        } else {
#pragma unroll
            for (int subi = 0; subi < 2; ++subi) {
                const int sub = 1 - subi;
                if (kt == kt_d && sub > dsub) continue;
                const bool diag = (kt == kt_d && sub == dsub);
                f32x16 s;
#pragma unroll
                for (int r = 0; r < 16; ++r) s[r] = 0.f;
#pragma unroll
                for (int j = 0; j < 8; ++j) {
                    const bf16x8 kf = *(const LAS bf16x8*)(Ks + (32 * sub + r32) * KROWB + (16 * j + 8 * hi) * 2);
                    s = MFMA32(kf, qf[j], s);
                }
                const int kvbase = kt * 64 + 32 * sub;
                float lk[16], yl[16];
#pragma unroll
                for (int r = 0; r < 16; ++r) {
                    const float y = s[r] * c1;
                    const float e = fast_exp2(-fabsf(y));
                    const float L = fmaxf(y, 0.f) + fast_log2(1.0f + e);
                    const bool valid = !diag || (kvbase + crow(r, hi) < tq);
                    lk[r] = valid ? -L : 0.f;
                    yl[r] = valid ? (y - L) : -1e30f;
                }
                float gs[4], pgs[4];
#pragma unroll
                for (int g = 0; g < 4; ++g) { gs[g] = (lk[4 * g] + lk[4 * g + 1]) + (lk[4 * g + 2] + lk[4 * g + 3]); pgs[g] = x32_other(gs[g], hi); }
                const float T0 = gs[0] + pgs[0], T1 = gs[1] + pgs[1], T2 = gs[2] + pgs[2], T3 = gs[3] + pgs[3];
                float Sg[4]; Sg[3] = 0.f; Sg[2] = T3; Sg[1] = T3 + T2; Sg[0] = T3 + T2 + T1;
                float a[16];
#pragma unroll
                for (int g = 0; g < 4; ++g) {
                    float c = Crun + Sg[g] + (hi == 0 ? pgs[g] : 0.f);
                    a[4 * g + 3] = fast_exp2(yl[4 * g + 3] + c); c += lk[4 * g + 3];
                    a[4 * g + 2] = fast_exp2(yl[4 * g + 2] + c); c += lk[4 * g + 2];
                    a[4 * g + 1] = fast_exp2(yl[4 * g + 1] + c); c += lk[4 * g + 1];
                    a[4 * g + 0] = fast_exp2(yl[4 * g + 0] + c);
                }
                Crun += Sg[0] + T0;
                bf16x8 pf[2];
#pragma unroll
                for (int s2 = 0; s2 < 2; ++s2) {
                    u32x4 w; w.x = pk2(a[8 * s2 + 0], a[8 * s2 + 1]); w.y = pk2(a[8 * s2 + 2], a[8 * s2 + 3]);
                    w.z = pk2(a[8 * s2 + 4], a[8 * s2 + 5]); w.w = pk2(a[8 * s2 + 6], a[8 * s2 + 7]);
                    pf[s2] = __builtin_bit_cast(bf16x8, w);
                }
                {
#define VFRAG(blk_, s2_) ({ const lptr vb_ = Vs + (32 * (blk_) + r32) * VROWB + 2 * (32 * sub + 16 * (s2_) + 4 * hi); const s16x4 lo_ = *(const LAS s16x4*)vb_, hi_ = *(const LAS s16x4*)(vb_ + 16); (bf16x8)__builtin_shufflevector(lo_, hi_, 0, 1, 2, 3, 4, 5, 6, 7); })
                    bf16x8 vcur[2], vnxt[2];
                    vcur[0] = VFRAG(0, 0); vcur[1] = VFRAG(0, 1);
#pragma unroll
                    for (int blk = 0; blk < 4; ++blk) {
                        if (blk < 3) { vnxt[0] = VFRAG(blk + 1, 0); vnxt[1] = VFRAG(blk + 1, 1); }
                        O[blk] = MFMA32(vcur[0], pf[0], O[blk]); O[blk] = MFMA32(vcur[1], pf[1], O[blk]);
                        vcur[0] = vnxt[0]; vcur[1] = vnxt[1];
                    }
#undef VFRAG
                }
            }
            if (__all(Crun < -160.0f)) wdone = true;
        }
        }
        if (MODE) { if (lane == 0) stat[8 * (kt & 1) + wid] = wdone ? 1 : 0; }
    }
#undef ATT_STORE
#undef ATT_HEAD
    __builtin_amdgcn_s_setprio(0);
#undef ATT_LOAD
    if (MODE == 1) {
        bf16_t* orow = AO + (rowbase + tq) * DM + 512 + h * 128;
#pragma unroll
        for (int blk = 0; blk < 4; ++blk)
#pragma unroll
            for (int g = 0; g < 4; ++g) {
                u32x2 w; w.x = pk2(O[blk][4 * g], O[blk][4 * g + 1]); w.y = pk2(O[blk][4 * g + 2], O[blk][4 * g + 3]);
                *(u32x2*)(orow + 32 * blk + 8 * g + 4 * hi) = w;
            }
    } else {
        const float ltot = x32_sum(lrun);
        const float inv = 1.0f / ltot;
        LAS float* X = (LAS float*)(sm + OFF_X);
        if (wid >= 4) {
#pragma unroll
            for (int blk = 0; blk < 4; ++blk)
#pragma unroll
                for (int r = 0; r < 16; ++r) X[(((wid - 4) * 64 + blk * 16 + r) << 6) + lane] = O[blk][r] * inv;
        }
        __syncthreads();
        if (wid < 4) {
            float ss = 0.f;
#pragma unroll
            for (int blk = 0; blk < 4; ++blk)
#pragma unroll
                for (int r = 0; r < 16; ++r) { const float o = O[blk][r] * inv - lam * X[((wid * 64 + blk * 16 + r) << 6) + lane]; O[blk][r] = o; ss += o * o; }
            ss = x32_sum(ss);
            const float rs = rsqrtf(ss * (1.0f / 128.0f) + RMS_EPS) * (1.0f - lam_init);
            bf16_t* orow = AO + (rowbase + tq) * DM + h * 128;
#pragma unroll
            for (int blk = 0; blk < 4; ++blk)
#pragma unroll
                for (int g = 0; g < 4; ++g) {
                    const int dv = 32 * blk + 8 * g + 4 * hi;
                    const f32x4 wv = *(const f32x4*)(subln + dv);
                    u32x2 w; w.x = pk2(O[blk][4 * g] * rs * wv[0], O[blk][4 * g + 1] * rs * wv[1]); w.y = pk2(O[blk][4 * g + 2] * rs * wv[2], O[blk][4 * g + 3] * rs * wv[3]);
                    *(u32x2*)(orow + dv) = w;
                }
        }
    }
}

__device__ __forceinline__ void phase(const bf16_t* P, bf16_t* AO, const float* lamp, const float* subln, int layer, unsigned* ctr, lptr sm) {
    asm volatile("" : "+s"(layer));
    const float lam_init = 0.8f - 0.6f * expf(-0.3f * (float)layer);
    float d1 = 0.f, d2 = 0.f;
    for (int i = 0; i < 64; ++i) { d1 += lamp[i] * lamp[64 + i]; d2 += lamp[128 + i] * lamp[192 + i]; }
    const float lam = expf(d1) - expf(d2) + lam_init;
    LAS int* nxt = (LAS int*)(sm + OFF_STAT + 128);
    for (;;) {
        __syncthreads();
        if (threadIdx.x == 0) nxt[0] = (int)__hip_atomic_fetch_add(ctr, 1u, __ATOMIC_RELAXED, __HIP_MEMORY_SCOPE_AGENT);
        __syncthreads();
        const int u = nxt[0];
        if (u >= 768) break;
        if (u < 512) {
            const int hh = 3 - (u >> 7), v = u & 127;
            unit<0>(P, AO, v & 3, hh, 31 - (v >> 2), sm, lam, subln, lam_init);
        } else {
            const int w = u - 512, bh = w & 15;
            unit<1>(P, AO, bh >> 2, bh & 3, 15 - (w >> 4), sm, lam, subln, lam_init);
        }
    }
}
}

namespace gdn {
constexpr int PLD = 4096;
constexpr int RB = 272, TB = 144;
constexpr int OFF_QS = 0, OFF_KS = 64 * RB, OFF_KBT = OFF_KS + 64 * RB, OFF_VBT = OFF_KBT + 128 * TB, OFF_LF = OFF_VBT + 128 * TB, OFF_TF = OFF_LF + 64 * 65 * 4,
              OFF_MF = OFF_TF + 64 * 68 * 4, OFF_TBF = OFF_MF + 16 * 68 * 4, OFF_GC = OFF_TBF + 64 * TB, OFF_BETA = OFF_GC + 256, OFF_END = OFF_BETA + 256;
static_assert(OFF_END <= 131072, "gdn LDS");

__device__ __forceinline__ void chunk_phase(const bf16_t* P, const float* ABv, const float* convw, const float* alog, const float* dtb, unsigned char* ws, lptr sm) {
    const int tid = opaque_tid(), lane = tid & 63, wid = __builtin_amdgcn_readfirstlane(tid >> 6), r32 = lane & 31, hi = lane >> 5;
    LAS float* gcs = (LAS float*)(sm + OFF_GC); LAS float* betas = (LAS float*)(sm + OFF_BETA);
    LAS float* Lf = (LAS float*)(sm + OFF_LF); LAS float* Tf = (LAS float*)(sm + OFF_TF); LAS float* Mf = (LAS float*)(sm + OFF_MF);
    const int part = tid >> 7, o = tid & 15, tg = (tid & 127) >> 4;
    u32x4 xr[11]; float braw = 0.f, araw = 0.f;
#define CHUNK_PREFETCH(unx) do { const int n_ = (unx) & 63, h_ = ((unx) >> 6) & 7, b_ = (unx) >> 9; \
        if (part < 3) { const int ch_ = part * 1024 + h_ * 128 + 8 * o; \
            _Pragma("unroll") for (int rr = 0; rr < 11; ++rr) { const int sp = n_ * 64 + 8 * tg + rr - 3; \
                if (sp >= 0) xr[rr] = *(const u32x4*)(P + ((size_t)b_ * SEQ + sp) * PLD + ch_); else xr[rr] = (u32x4){0u, 0u, 0u, 0u}; } \
            } \
        if (tid < 64) { const size_t t_ = (size_t)b_ * SEQ + (size_t)n_ * 64 + tid; braw = ABv[t_ * 16 + h_]; araw = ABv[t_ * 16 + 8 + h_]; } } while (0)
    if ((int)blockIdx.x < 2048) CHUNK_PREFETCH((int)blockIdx.x);
#pragma nounroll
    for (int un = blockIdx.x; un < 2048; un += gridDim.x) {
    int tid_l = tid; asm volatile("" : "+v"(tid_l));
    const int tid = tid_l, lane = tid & 63, wid = __builtin_amdgcn_readfirstlane(tid >> 6), r32 = lane & 31, hi = lane >> 5;
    const int part = tid >> 7, o = tid & 15, tg = (tid & 127) >> 4;
    const int n = un & 63, h = (un >> 6) & 7, b = un >> 9;
    const size_t tok0 = (size_t)b * SEQ + (size_t)n * 64;
    f32x4 wq[8];
    if (part < 3) { const int ch = part * 1024 + h * 128 + 8 * o;
#pragma unroll
        for (int k = 0; k < 4; ++k) { wq[2 * k] = *(const f32x4*)(convw + (size_t)k * 3072 + ch); wq[2 * k + 1] = *(const f32x4*)(convw + (size_t)k * 3072 + ch + 4); } }
    BAR_LDS();
    if (tid < 64) {
        const float beta = 1.0f / (1.0f + expf(-braw));
        const float xx = araw + dtb[h];
        const float sp = fmaxf(xx, 0.f) + log1pf(expf(-fabsf(xx)));
        float g = -expf(alog[h]) * sp;
#pragma unroll
        for (int o2 = 1; o2 < 64; o2 <<= 1) { const float t = __shfl_up(g, o2); if (lane >= o2) g += t; }
        gcs[tid] = g; betas[tid] = beta;
    }
    for (int i = tid; i < 64 * 68; i += 512) Tf[i] = 0.f;
    BAR_LDS();
    const float gl = gcs[63];
    {
        if (part < 3) {
            float y[8][8];
#pragma unroll
            for (int i = 0; i < 8; ++i) {
#pragma unroll
                for (int c = 0; c < 8; ++c) {
                    float acc = 0.f;
#pragma unroll
                    for (int k = 0; k < 4; ++k) { const unsigned u = xr[i + k][c >> 1]; acc += wq[2 * k + (c >> 2)][c & 3] * ((c & 1) ? bf_hi(u) : bf_lo(u)); }
                    y[i][c] = silu_f(acc);
                }
            }
            if (part < 2) {
#pragma unroll
                for (int i = 0; i < 8; ++i) {
                    float ss = 0.f;
#pragma unroll
                    for (int c = 0; c < 8; ++c) ss += y[i][c] * y[i][c];
                    ss = row16_sum(ss);
                    const float rn = rsqrtf(ss + 1e-6f) * (part == 0 ? 0.08838834764831845f : 1.0f);
#pragma unroll
                    for (int c = 0; c < 8; ++c) y[i][c] *= rn;
                }
            }
            if (part == 0) {
                bf16_t* QD = (bf16_t*)(ws + WS_QD) + (size_t)un * 8192;
#pragma unroll
                for (int i = 0; i < 8; ++i) {
                    const int tk = 8 * tg + i; const float eg = fexp(gcs[tk]);
                    u32x4 w; w.x = pk2(y[i][0], y[i][1]); w.y = pk2(y[i][2], y[i][3]); w.z = pk2(y[i][4], y[i][5]); w.w = pk2(y[i][6], y[i][7]);
                    *(LAS u32x4*)(sm + OFF_QS + tk * RB + 16 * o) = w;
                    u32x4 d; d.x = pk2(y[i][0] * eg, y[i][1] * eg); d.y = pk2(y[i][2] * eg, y[i][3] * eg); d.z = pk2(y[i][4] * eg, y[i][5] * eg); d.w = pk2(y[i][6] * eg, y[i][7] * eg);
                    *(u32x4*)(QD + (((((tk >> 5) * 8 + (o >> 1)) * 64) + (tk & 31) + 32 * (o & 1)) << 3)) = d;
                }
            } else if (part == 1) {
                bf16_t* KDT = (bf16_t*)(ws + WS_KDT) + (size_t)un * 8192;
                float f1[8], f2[8];
#pragma unroll
                for (int i = 0; i < 8; ++i) { const int tk = 8 * tg + i; const float gi = gcs[tk]; f1[i] = betas[tk] * fexp(gi); f2[i] = fexp(gl - gi);
                    u32x4 w; w.x = pk2(y[i][0], y[i][1]); w.y = pk2(y[i][2], y[i][3]); w.z = pk2(y[i][4], y[i][5]); w.w = pk2(y[i][6], y[i][7]);
                    *(LAS u32x4*)(sm + OFF_KS + tk * RB + 16 * o) = w; }
#pragma unroll
                for (int c = 0; c < 8; ++c) {
                    u32x4 w; w.x = pk2(y[0][c] * f1[0], y[1][c] * f1[1]); w.y = pk2(y[2][c] * f1[2], y[3][c] * f1[3]); w.z = pk2(y[4][c] * f1[4], y[5][c] * f1[5]); w.w = pk2(y[6][c] * f1[6], y[7][c] * f1[7]);
                    *(LAS u32x4*)(sm + OFF_KBT + (8 * o + c) * TB + 16 * tg) = w;
                    u32x4 d; d.x = pk2(y[0][c] * f2[0], y[1][c] * f2[1]); d.y = pk2(y[2][c] * f2[2], y[3][c] * f2[3]); d.z = pk2(y[4][c] * f2[4], y[5][c] * f2[5]); d.w = pk2(y[6][c] * f2[6], y[7][c] * f2[7]);
                    { const int dk = 8 * o + c; *(u32x4*)(KDT + (((((dk >> 5) * 4 + (tg >> 1)) * 64) + (dk & 31) + 32 * (tg & 1)) << 3)) = d; }
                }
            } else {
                float f1[8];
#pragma unroll
                for (int i = 0; i < 8; ++i) f1[i] = betas[8 * tg + i];
#pragma unroll
                for (int c = 0; c < 8; ++c) {
                    u32x4 w; w.x = pk2(y[0][c] * f1[0], y[1][c] * f1[1]); w.y = pk2(y[2][c] * f1[2], y[3][c] * f1[3]); w.z = pk2(y[4][c] * f1[4], y[5][c] * f1[5]); w.w = pk2(y[6][c] * f1[6], y[7][c] * f1[7]);
                    *(LAS u32x4*)(sm + OFF_VBT + (8 * o + c) * TB + 16 * tg) = w;
                }
            }
        }
    }
    __syncthreads();
    { const int nu = un + (int)gridDim.x; if (nu < 2048) CHUNK_PREFETCH(nu); }
    {
        const int mat = wid >> 2, bi = (wid & 3) >> 1, bj = wid & 1;
        f32x16 s;
#pragma unroll
        for (int r = 0; r < 16; ++r) s[r] = 0.f;
#pragma unroll
        for (int jh = 0; jh < 2; ++jh) {
            bf16x8 af[4], bf[4];
#pragma unroll
            for (int j = 0; j < 4; ++j) {
                af[j] = *(const LAS bf16x8*)(sm + (mat ? OFF_QS : OFF_KS) + (32 * bi + r32) * RB + (16 * (4 * jh + j) + 8 * hi) * 2);
                bf[j] = *(const LAS bf16x8*)(sm + OFF_KS + (32 * bj + r32) * RB + (16 * (4 * jh + j) + 8 * hi) * 2);
            }
#pragma unroll
            for (int j = 0; j < 4; ++j) s = MFMA32(af[j], bf[j], s);
        }
        const int jj = 32 * bj + r32; const float gj = gcs[jj];
        bf16_t* AQK = (bf16_t*)(ws + WS_AQK) + (size_t)un * 4096;
#pragma unroll
        for (int r = 0; r < 16; ++r) {
            const int ii = 32 * bi + crow(r, hi);
            const float dec = fexp(fminf(gcs[ii] - gj, 0.f));
            if (mat == 0) Lf[ii * 65 + jj] = (ii > jj) ? betas[ii] * s[r] * dec : 0.f;
            else AQK[((((ii >> 5) * 4 + (jj >> 4)) * 64 + (ii & 31) + 32 * ((jj >> 3) & 1)) << 3) + (jj & 7)] = (bf16_t)(pk2((ii >= jj) ? s[r] * dec : 0.f, 0.f) & 0xffffu);
        }
    }
    __syncthreads();
    if (tid < 64) {
        const int I = tid >> 4, c = tid & 15;
        float x[16];
#pragma unroll
        for (int i = 0; i < 16; ++i) {
            float v = (i == c) ? 1.f : 0.f;
#pragma unroll
            for (int j = 0; j < i; ++j) v -= Lf[(16 * I + i) * 65 + 16 * I + j] * x[j];
            x[i] = v;
        }
#pragma unroll
        for (int i = 0; i < 16; ++i) Tf[(16 * I + i) * 68 + 16 * I + c] = x[i];
    }
    __syncthreads();
#pragma nounroll
    for (int I = 1; I < 4; ++I) {
        const int ng = 4 * I;
        if (tid < 16 * ng) {
            const int i = tid / ng, c4 = (tid % ng) * 4;
            f32x4 acc = {0.f, 0.f, 0.f, 0.f};
            const LAS float* lrow = Lf + (16 * I + i) * 65;
#pragma unroll 8
            for (int k = 0; k < 16 * I; ++k) acc += *(const LAS f32x4*)(Tf + k * 68 + c4) * lrow[k];
            *(LAS f32x4*)(Mf + i * 68 + c4) = acc;
        }
        __syncthreads();
        if (tid < 16 * ng) {
            const int i = tid / ng, c4 = (tid % ng) * 4;
            f32x4 acc = {0.f, 0.f, 0.f, 0.f};
            const LAS float* drow = Tf + (16 * I + i) * 68 + 16 * I;
#pragma unroll
            for (int k = 0; k < 16; ++k) acc += *(const LAS f32x4*)(Mf + k * 68 + c4) * drow[k];
            *(LAS f32x4*)(Tf + (16 * I + i) * 68 + c4) = -acc;
        }
        __syncthreads();
    }
    for (int e = tid; e < 64 * 32; e += 512) {
        const int i = e >> 5, j2 = (e & 31) * 2;
        *(LAS unsigned*)(sm + OFF_TBF + i * TB + j2 * 2) = pk2(Tf[i * 68 + j2], Tf[i * 68 + j2 + 1]);
    }
    __syncthreads();
    {
        const int mat = wid >> 2, bi = (wid & 3) >> 1;
        float* U = (float*)(ws + WS_U);
        bf16_t* WG = (bf16_t*)(ws + WS_WG) + (size_t)un * 8192;
#pragma unroll
        for (int cc = 0; cc < 2; ++cc) {
            const int bc = 2 * (wid & 1) + cc;
            f32x16 s;
#pragma unroll
            for (int r = 0; r < 16; ++r) s[r] = 0.f;
            {
                bf16x8 af[4], bf[4];
#pragma unroll
                for (int k = 0; k < 4; ++k) {
                    af[k] = *(const LAS bf16x8*)(sm + OFF_TBF + (32 * bi + r32) * TB + (16 * k + 8 * hi) * 2);
                    bf[k] = *(const LAS bf16x8*)(sm + (mat ? OFF_KBT : OFF_VBT) + (32 * bc + r32) * TB + (16 * k + 8 * hi) * 2);
                }
#pragma unroll
                for (int k = 0; k < 4; ++k) s = MFMA32(af[k], bf[k], s);
            }
#pragma unroll
            for (int r = 0; r < 16; ++r) {
                const int ii = 32 * bi + crow(r, hi), c = 32 * bc + r32;
                if (mat == 0) U[(tok0 + ii) * DM + h * 128 + c] = s[r];
                else WG[((((ii >> 5) * 8 + (c >> 4)) * 64 + (ii & 31) + 32 * ((c >> 3) & 1)) << 3) + (c & 7)] = (bf16_t)(pk2(s[r], 0.f) & 0xffffu);
            }
        }
    }
    if (tid == 0) ((float*)(ws + WS_CD))[un] = expf(gcs[63]);
    }
#undef CHUNK_PREFETCH
}

constexpr int OFF_ST = 0, OFF_VN = 32 * RB;
__device__ __forceinline__ void scan_task(int task, unsigned char* ws, bf16_t* OB, lptr sm) {
    const int tid = opaque_tid(), lane = tid & 63, wid = __builtin_amdgcn_readfirstlane(tid >> 6), r32 = lane & 31, hi = lane >> 5;
    const int bh = task >> 2, sl = task & 3, b = bh >> 3, h = bh & 7, e0 = 32 * sl;
    const int role = wid < 2 ? 0 : (wid < 4 ? 1 : 2);
    const int rb = wid < 2 ? wid : (wid < 4 ? wid - 2 : wid - 4);
    const bf16_t* WG = (const bf16_t*)(ws + WS_WG); const bf16_t* QD = (const bf16_t*)(ws + WS_QD); const bf16_t* KDT = (const bf16_t*)(ws + WS_KDT);
    const bf16_t* AQK = (const bf16_t*)(ws + WS_AQK); float* U = (float*)(ws + WS_U); const float* CD = (const float*)(ws + WS_CD);
    __syncthreads();
    for (int i = tid; i < (32 * RB + 32 * TB) / 4; i += 512) ((LAS unsigned*)sm)[i] = 0u;
    f32x16 Sacc;
#pragma unroll
    for (int r = 0; r < 16; ++r) Sacc[r] = 0.f;
    bf16x8 faA[8], faB[8], faC[8]; u32x4 fxA[4], fxB[4], fxC[4];
    const size_t ubase = ((size_t)b * SEQ + 32 * rb + 4 * hi) * DM + h * 128 + e0 + r32;
    const size_t abase = (size_t)bh * 64 * 8192 + ((size_t)rb * 512 + lane) * 8;
    const size_t kbase = (size_t)bh * 64 * 8192 + ((size_t)rb * 256 + lane) * 8;
    const size_t qbase = (size_t)bh * 64 * 4096 + ((size_t)rb * 256 + lane) * 8;
#define NCL(nn) ((nn) < 63 ? (nn) : 63)
#define LOAD_R0(nn, FA, FX) do { const int n_ = NCL(nn); \
        _Pragma("unroll") for (int j = 0; j < 8; ++j) FA[j] = *(const bf16x8*)(WG + abase + (size_t)n_ * 8192 + 512 * j); \
        _Pragma("unroll") for (int r = 0; r < 16; ++r) FX[r >> 2][r & 3] = __float_as_uint(U[ubase + (size_t)(n_ * 64 + (r & 3) + 8 * (r >> 2)) * DM]); } while (0)
#define LOAD_R1(nn, FA, FX) do { const int n_ = NCL(nn); \
        _Pragma("unroll") for (int j = 0; j < 8; ++j) FA[j] = *(const bf16x8*)(QD + abase + (size_t)n_ * 8192 + 512 * j); \
        _Pragma("unroll") for (int j = 0; j < 4; ++j) FX[j] = *(const u32x4*)(AQK + qbase + (size_t)n_ * 4096 + 512 * j); } while (0)
#define LOAD_R2(nn, FA, FX) do { const int n_ = NCL(nn); \
        _Pragma("unroll") for (int j = 0; j < 4; ++j) FA[j] = *(const bf16x8*)(KDT + kbase + (size_t)n_ * 8192 + 512 * j); FX[0][0] = __float_as_uint(CD[(size_t)bh * 64 + n_]); } while (0)
#define STEP_R0(nn, FA, FX, LFA, LFX) do { LOAD_R0((nn) + 2, LFA, LFX); \
        f32x16 acc; _Pragma("unroll") for (int r = 0; r < 16; ++r) acc[r] = 0.f; \
        _Pragma("unroll") for (int j = 0; j < 8; ++j) { const bf16x8 sb = *(const LAS bf16x8*)(sm + OFF_ST + r32 * RB + (16 * j + 8 * hi) * 2); acc = MFMA32(FA[j], sb, acc); } \
        _Pragma("unroll") for (int g = 0; g < 4; ++g) { \
            u32x2 w; w.x = pk2(__uint_as_float(FX[g][0]) - acc[4 * g], __uint_as_float(FX[g][1]) - acc[4 * g + 1]); w.y = pk2(__uint_as_float(FX[g][2]) - acc[4 * g + 2], __uint_as_float(FX[g][3]) - acc[4 * g + 3]); \
            *(LAS u32x2*)(sm + OFF_VN + r32 * TB + 2 * (32 * rb + 8 * g + 4 * hi)) = w; } \
        BAR_LDS(); BAR_LDS(); } while (0)
#define STEP_R1(nn, FA, FX, LFA, LFX) do { LOAD_R1((nn) + 2, LFA, LFX); \
        f32x16 acc; _Pragma("unroll") for (int r = 0; r < 16; ++r) acc[r] = 0.f; \
        _Pragma("unroll") for (int j = 0; j < 8; ++j) { const bf16x8 sb = *(const LAS bf16x8*)(sm + OFF_ST + r32 * RB + (16 * j + 8 * hi) * 2); acc = MFMA32(FA[j], sb, acc); } \
        BAR_LDS(); \
        _Pragma("unroll") for (int k = 0; k < 4; ++k) { const bf16x8 vb = *(const LAS bf16x8*)(sm + OFF_VN + r32 * TB + (16 * k + 8 * hi) * 2); acc = MFMA32(__builtin_bit_cast(bf16x8, FX[k]), vb, acc); } \
        _Pragma("unroll") for (int r = 0; r < 16; r += 2) { const unsigned w_ = pk2(acc[r], acc[r + 1]); OB[ubase + (size_t)((nn) * 64 + (r & 3) + 8 * (r >> 2)) * DM] = (bf16_t)(w_ & 0xffffu); OB[ubase + (size_t)((nn) * 64 + ((r + 1) & 3) + 8 * ((r + 1) >> 2)) * DM] = (bf16_t)(w_ >> 16); } \
        BAR_LDS(); } while (0)
#define STEP_R2(nn, FA, FX, LFA, LFX) do { LOAD_R2((nn) + 2, LFA, LFX); \
        BAR_LDS(); \
        Sacc = Sacc * __uint_as_float(FX[0][0]); \
        _Pragma("unroll") for (int k = 0; k < 4; ++k) { const bf16x8 vb = *(const LAS bf16x8*)(sm + OFF_VN + r32 * TB + (16 * k + 8 * hi) * 2); Sacc = MFMA32(FA[k], vb, Sacc); } \
        _Pragma("unroll") for (int g = 0; g < 4; ++g) { u32x2 w; w.x = pk2(Sacc[4 * g], Sacc[4 * g + 1]); w.y = pk2(Sacc[4 * g + 2], Sacc[4 * g + 3]); \
            *(LAS u32x2*)(sm + OFF_ST + r32 * RB + 2 * (32 * rb + 8 * g + 4 * hi)) = w; } \
        BAR_LDS(); } while (0)
#define ROLE_LOOP(LOADM, STEPM) do { LOADM(0, faA, fxA); LOADM(1, faB, fxB); BAR_LDS(); \
        _Pragma("nounroll") for (int n = 0; n < 64; n += 3) { STEPM(n, faA, fxA, faC, fxC); if (n + 1 < 64) { STEPM(n + 1, faB, fxB, faA, fxA); STEPM(n + 2, faC, fxC, faB, fxB); } } } while (0)
    if (role == 0) ROLE_LOOP(LOAD_R0, STEP_R0);
    else if (role == 1) ROLE_LOOP(LOAD_R1, STEP_R1);
    else ROLE_LOOP(LOAD_R2, STEP_R2);
#undef NCL
#undef LOAD_R0
#undef LOAD_R1
#undef LOAD_R2
#undef STEP_R0
#undef STEP_R1
#undef STEP_R2
#undef ROLE_LOOP
}

__device__ __forceinline__ void post_phase(const bf16_t* O, const bf16_t* P, const float* nw, bf16_t* H) {
    const int tid = opaque_tid(), lane = tid & 63, wave = tid >> 6;
    const int gw = blockIdx.x * 8 + wave, NGW = gridDim.x * 8;
    const f32x4 wv = *(const f32x4*)(nw + ((4 * lane) & 127));
    for (int m = gw; m < M; m += NGW) {
        const u32x2* orow = (const u32x2*)(O + (size_t)m * DM) + lane;
        const u32x2* grow = (const u32x2*)(P + (size_t)m * PLD + 3072) + lane;
        u32x2* hrow = (u32x2*)(H + (size_t)m * DM) + lane;
#pragma unroll
        for (int j = 0; j < 4; ++j) {
            const u32x2 ov = orow[64 * j]; const f32x4 v = {bf_lo(ov.x), bf_hi(ov.x), bf_lo(ov.y), bf_hi(ov.y)}; const u32x2 gq = grow[64 * j];
            float ss = (v[0] * v[0] + v[1] * v[1]) + (v[2] * v[2] + v[3] * v[3]);
            ss = x16_sum(row16_sum(ss));
            const float rs = rsqrtf(ss * (1.0f / 128.0f) + RMS_EPS);
            u32x2 o; o.x = pk2(v[0] * rs * wv[0] * silu_f(bf_lo(gq.x)), v[1] * rs * wv[1] * silu_f(bf_hi(gq.x)));
            o.y = pk2(v[2] * rs * wv[2] * silu_f(bf_lo(gq.y)), v[3] * rs * wv[3] * silu_f(bf_hi(gq.y)));
            hrow[64 * j] = o;
        }
    }
}
}


#define GAS __attribute__((address_space(1)))
#define XB_TMO      32
#define XB_XCNT(j)  (64   + 32 * (j))
#define XB_XSUB(j)  (576  + 32 * (j))
#define XB_XGEN(j)  (1088 + 32 * (j))
#define XB_TOP      1600
#define XB_TOPGEN   1632
#define XCD_BAR_WORDS 1664
#define XB_SPIN_CAP (1u << 18)

__device__ __forceinline__ unsigned xb_ld(unsigned* p)              { return __hip_atomic_load(p, __ATOMIC_RELAXED, __HIP_MEMORY_SCOPE_AGENT); }
__device__ __forceinline__ unsigned xb_add(unsigned* p, unsigned v) { return __hip_atomic_fetch_add(p, v, __ATOMIC_RELAXED, __HIP_MEMORY_SCOPE_AGENT); }
__device__ __forceinline__ unsigned xb_xcc_id() { return (unsigned)__builtin_amdgcn_s_getreg((3 << 11) | 20) & 0xFu; }
#define XB_SPIN(cond, bar) do { unsigned _sp = 0; while (cond) { __builtin_amdgcn_s_sleep(1); \
    if ((++_sp & 255u) == 0u) { if (xb_ld(&(bar)[XB_TMO])) break; if (_sp > XB_SPIN_CAP) { atomicAdd(&(bar)[XB_TMO], 1u); break; } } } } while (0)

struct XcdBarrier {
    unsigned* bar; unsigned x;
    volatile LAS unsigned* st;
};

__device__ __forceinline__ XcdBarrier xcd_barrier_post(unsigned* bar, volatile LAS unsigned* st) {
    XcdBarrier b; b.bar = bar; b.x = xb_xcc_id(); b.st = st;
    if (threadIdx.x == 0) (void)xb_add(&bar[XB_XCNT(b.x)], 1u);
    return b;
}
__device__ __forceinline__ void xcd_barrier_complete(unsigned* bar, unsigned x, unsigned& nloc, unsigned& nx) {
    const unsigned G = gridDim.x * gridDim.y * gridDim.z;
    unsigned sum, cnt, mine, sp = 0u;
    for (;;) {
        sum = 0u; cnt = 0u; mine = 0u;
#pragma unroll
        for (unsigned j = 0; j < 16; ++j) { const unsigned c = xb_ld(&bar[XB_XCNT(j)]); sum += c; cnt += (c > 0u) ? 1u : 0u; mine = (j == x) ? c : mine; }
        if (sum == G) break;
        __builtin_amdgcn_s_sleep(1);
        if ((++sp & 255u) == 0u) { if (xb_ld(&bar[XB_TMO])) break; if (sp > XB_SPIN_CAP) { atomicAdd(&bar[XB_TMO], 1u); break; } }
    }
    nloc = mine > 0u ? mine : 1u; nx = cnt > 0u ? cnt : 1u;
}

__device__ __forceinline__ void xcd_barrier(const XcdBarrier& b) {
    asm volatile("s_waitcnt vmcnt(0)" ::: "memory");
    __syncthreads();
    if (threadIdx.x == 0) {
        unsigned* bar = b.bar;
        __builtin_amdgcn_s_waitcnt(0);
        unsigned nloc = b.st[0], nx = b.st[1];
        if (nloc == 0u) { xcd_barrier_complete(bar, b.x, nloc, nx); b.st[0] = nloc; b.st[1] = nx; }
        const unsigned old = xb_add(&bar[XB_XSUB(b.x)], 1u);
        const unsigned gen = old / nloc;
        if (old + 1u == (gen + 1u) * nloc) {
            __builtin_amdgcn_fence(__ATOMIC_RELEASE, "agent");
            asm volatile("s_waitcnt vmcnt(0)" ::: "memory");
            const unsigned og = xb_add(&bar[XB_TOP], 1u);
            const unsigned tg = og / nx;
            if (og + 1u == (tg + 1u) * nx) xb_add(&bar[XB_TOPGEN], 1u);
            else XB_SPIN(xb_ld(&bar[XB_TOPGEN]) == tg, bar);
            __builtin_amdgcn_fence(__ATOMIC_ACQUIRE, "agent");
            xb_add(&bar[XB_XGEN(b.x)], 1u);
            asm volatile("s_waitcnt vmcnt(0)" ::: "memory");
        } else {
            XB_SPIN(xb_ld(&bar[XB_XGEN(b.x)]) == gen, bar);
            __builtin_amdgcn_fence(__ATOMIC_ACQUIRE, "agent");
            asm volatile("s_waitcnt vmcnt(0)" ::: "memory");
        }
    }
    __syncthreads();
}
#ifndef PM
#define PM 0xFFFF
#endif
#define GSYNC() do { xcd_barrier(xbar); if (PROBE & 0x1000) xcd_barrier(xbar); } while (0)
__global__ void __launch_bounds__(512, 2) fwd_megakernel(Params p) {
    cg::grid_group grid = cg::this_grid();
    grid.sync();
    const lptr lds = (lptr)lds_raw;
    volatile LAS unsigned* xst = (volatile LAS unsigned*)(lds + 139264);
    if (threadIdx.x == 0) { xst[0] = 0u; xst[1] = 0u; }
    __syncthreads();
    XcdBarrier xbar = xcd_barrier_post((unsigned*)(p.ws + WS_BAR), xst);
    unsigned char* ws = p.ws;
    bf16_t* H = (bf16_t*)p.out;
    bf16_t* XB = (bf16_t*)(ws + WS_H);
    bf16_t* PROJ = (bf16_t*)(ws + WS_R1);
    bf16_t* HID = (bf16_t*)(ws + WS_HID);
    float* ABv = (float*)(ws + WS_AB);
    float* SS = (float*)(ws + WS_SS);
#pragma nounroll
    for (int l = 0; l < 4; ++l) {
        const bool odd = l & 1; const int e = l >> 1;
#pragma nounroll
        for (int sbk = 0; sbk < 3; ++sbk) {
            const int ni = 3 * l + sbk;
            if (sbk != 1) {
                if (sbk == 0 && l == 0) {
                    convert_layer(p, 0, lds, 1, 0); __syncthreads();
                    prologue_phase(p.in[0], XB, SS);
                    GSYNC();
                }
                for (int rp = 0; rp < REPS(4); ++rp) { EpiSwiGLU E{HID, DFF, SS + (size_t)(ni & 1) * M * 16}; run_gemm(lds, XB, (const bf16_t*)(ws + (sbk == 0 ? WS_WGU1 : WS_WGU2)), 2 * DFF, DM, E); }
                if ((int)blockIdx.x >= (int)gridDim.x / 2) {
                    if (sbk == 0) convert_layer(p, l, lds, 2, (int)gridDim.x / 2);
                    else if (l < 3) convert_layer(p, l + 1, lds, 1, (int)gridDim.x / 2);
                }
                GSYNC();
                { EpiResid<true> E{XB, SS + (size_t)((ni + 1) & 1) * M * 16}; run_gemm(lds, HID, (const bf16_t*)(ws + (sbk == 0 ? WS_WD1 : WS_WD2)), DM, DFF, E); }
                GSYNC();
            } else {
                const float* nw = p.in[5] + (size_t)l * DM;
                if (odd) ab_phase(XB, nw, SS + (size_t)(ni & 1) * M * 16, p.in[10] + (size_t)e * DM * 4112 + 4096, ABv, lds);
                for (int rp = 0; rp < REPS(4); ++rp) { const int nin = odd ? 4096 : 3072; EpiBf16 E{PROJ, nin, SS + (size_t)(ni & 1) * M * 16}; run_gemm(lds, XB, (const bf16_t*)(ws + WS_WIN), nin, DM, E); }
                GSYNC();
                if (!odd) {
                    att::phase(PROJ, H, p.in[7] + (size_t)e * 256, p.in[8] + (size_t)e * 128, l, (unsigned*)(ws + WS_BAR + 14336) + 64 * e, lds);
                } else {
                    gdn::chunk_phase(PROJ, ABv, p.in[11] + (size_t)e * 4 * 3072, p.in[12] + e * 8, p.in[13] + e * 8, ws, lds);
                    GSYNC();
                    for (int rp = 0; rp < REPS(128); ++rp) for (int t = blockIdx.x; t < 128; t += gridDim.x) gdn::scan_task((((t & 7) * 4 + (t >> 5)) << 2) | ((t >> 3) & 3), ws, H, lds);
                    GSYNC();
                    gdn::post_phase(H, PROJ, p.in[14] + e * 128, H);
                }
                GSYNC();
                { EpiResid<false> E{XB, SS + (size_t)((ni + 1) & 1) * M * 16}; run_gemm(lds, H, (const bf16_t*)(ws + WS_WOUT), DM, DM, E); }
                GSYNC();
            }
        }
    }
    final_norm_phase(XB, p.out, p.in[20]);
}

extern "C" void kernel_launch(void* const* d_in, const int* in_sizes, int n_in, void* d_out, int out_size, void* d_ws, size_t ws_size, hipStream_t stream) {
    static int grid = 0;
    if (grid == 0) {
        if (n_in != 21 || out_size != M * DM || ws_size < WS_END) { fprintf(stderr, "kernel_launch: unexpected shapes (n_in %d out %d ws %zu, need %zu)\n", n_in, out_size, ws_size, (size_t)WS_END); grid = -1; return; }
        int dev = 0, cus = 0, per_cu = 0;
        hipGetDevice(&dev);
        hipDeviceGetAttribute(&cus, hipDeviceAttributeMultiprocessorCount, dev);
        if (hipFuncSetAttribute((const void*)fwd_megakernel, hipFuncAttributeMaxDynamicSharedMemorySize, LDS_BYTES) != hipSuccess) { fprintf(stderr, "kernel_launch: hipFuncSetAttribute failed\n"); grid = -1; return; }
        if (hipOccupancyMaxActiveBlocksPerMultiprocessor(&per_cu, (const void*)fwd_megakernel, 512, LDS_BYTES) != hipSuccess || per_cu < 1) { fprintf(stderr, "kernel_launch: occupancy query gave %d\n", per_cu); per_cu = 1; }
        (void)hipGetLastError();
        grid = cus * 1;
        if (grid > 256) grid = 256;
    }
    if (grid < 0) return;
    if (hipMemsetAsync((char*)d_ws + WS_BAR, 0, 16384, stream) != hipSuccess) { fprintf(stderr, "kernel_launch: memset failed\n"); return; }
    Params p{};
    for (int i = 0; i < 21; ++i) p.in[i] = (const float*)d_in[i];
    p.out = (float*)d_out; p.ws = (unsigned char*)d_ws;
    void* args[] = {&p};
    hipError_t e = hipLaunchCooperativeKernel((const void*)fwd_megakernel, dim3(grid), dim3(512), args, LDS_BYTES, stream);
    if (e != hipSuccess) fprintf(stderr, "cooperative launch failed: %s (grid %d)\n", hipGetErrorString(e), grid);
}
```

```cpp
#include <hip/hip_runtime.h>
#include <hip/hip_cooperative_groups.h>
#include <cstdio>
#include <cstdint>
namespace cg = cooperative_groups;
#ifndef PROBE
#define PROBE 0
#endif
#define REPS(bit) ((PROBE & (bit)) ? 2 : 1)
__device__ __forceinline__ int opaque_tid() { int t = (int)threadIdx.x; asm volatile("" : "+v"(t)); return t; }
namespace pg8 {
#define PG8_LAS __attribute__((address_space(3)))
typedef unsigned short bf16_t;
typedef short bf16x8 __attribute__((ext_vector_type(8)));
typedef float f32x4 __attribute__((ext_vector_type(4)));
typedef unsigned u32x4 __attribute__((ext_vector_type(4)));
constexpr int BM = 256, BK = 64, HALF = 128, HTB = HALF * BK * 2  , STAGE_BYTES = 8 * HTB, NXCD = 8, WGM = 8;

__host__ __device__ __forceinline__ int lds_byte(int r, int c) { const int st = (r >> 4) * 2 + (c >> 5), rr = r & 15, cc = c & 31, ob = rr * 64 + cc * 2; return st * 1024 + (ob ^ (((ob >> 9) & 1) << 5)); }
__host__ __device__ __forceinline__ void stage_rc(int b, int& R, int& C) { const int st = b / 1024, sb = b % 1024, swz = sb ^ (((sb >> 9) & 1) << 5); R = (st >> 1) * 16 + swz / 64; C = (st & 1) * 32 + (swz % 64) / 2; }
__host__ __device__ __forceinline__ int perm32(int rho) { const int n = rho >> 4, i = rho & 15; return 8 * (i >> 2) + 4 * n + (i & 3); }

struct Unit { int pm, pn; };
struct Gemm { const bf16_t* A; const bf16_t* Bt; int M, N, K; };

struct StaticOrder {
    int nM, nN, nwg, G, c;
    __host__ __device__ void init(int M, int N, int G_, int c_) { nM = M / BM; nN = N / BM; nwg = nM * nN; G = G_; c = c_; }
    __host__ __device__ bool next(int i, Unit& u) const {
        const long L = (long)i * G + c; if (L >= nwg) return false;
        int wgid = (int)L; { const int q = nwg / NXCD, r = nwg % NXCD, xcd = wgid % NXCD, off = wgid / NXCD; wgid = (xcd < r ? xcd * (q + 1) : r * (q + 1) + (xcd - r) * q) + off; }
        const int nig = WGM * nN, gid = wgid / nig, fm = gid * WGM, gsz = (nM - fm) < WGM ? (nM - fm) : WGM;
        u.pm = fm + ((wgid % nig) % gsz); u.pn = (wgid % nig) / gsz; return true;
    }
    __device__ __forceinline__ void a_ready(const Unit&) const {}
    __device__ __forceinline__ void done(const Unit&) const {}
};

template <class Epi, class Sched, bool ALIGN_EPI = false, bool SP2 = false>
__device__ __forceinline__ void gemm_phase(PG8_LAS unsigned char* lds, const Gemm g, const Sched& S, const Epi& E) {
    const int tid = opaque_tid(), wid = __builtin_amdgcn_readfirstlane(tid >> 6), lane = tid & 63, wr = wid >> 2, wc = wid & 3, fr = lane & 15, fq = lane >> 4;
    const int K = g.K, nt = K / BK;
    unsigned voffA[2], voffB[2];
#pragma unroll
    for (int i = 0; i < 2; ++i) { int R, C; stage_rc(tid * 16 + i * 8192, R, C); const int Rb = Epi::PERM ? ((R & ~31) + perm32(R & 31)) : R;
        voffA[i] = (unsigned)(R * K + C) * 2u; voffB[i] = (unsigned)(Rb * K + C) * 2u; }
    const size_t kstep = (size_t)(BK * 2);
    const size_t hstep = (size_t)HALF * K * 2;
    const size_t tstep = 2 * hstep;
    const unsigned ldsw = (unsigned)wid * 1024u;
    const int aoff = lds_byte(wr * 64 + fr, fq * 8), boff = lds_byte(wc * 32 + fr, fq * 8);
#define PG8_SA(b, h) (((b) * 2 + (h)) * HTB)
#define PG8_SB(b, h) ((4 + (b) * 2 + (h)) * HTB)
#define PG8_STAGE(bufoff, gbase, voff) do { _Pragma("unroll") for (int _i = 0; _i < 2; ++_i) \
        __builtin_amdgcn_global_load_lds((const unsigned*)((const char*)(gbase) + (voff)[_i]), (PG8_LAS unsigned*)(lds + (bufoff) + ldsw + _i * 8192), 16, 0, 0); } while (0)
#define PG8_LDA(dst, b, h) do { _Pragma("unroll") for (int m = 0; m < 4; ++m) _Pragma("unroll") for (int k = 0; k < 2; ++k) dst[m][k] = *(const PG8_LAS bf16x8*)(lds + PG8_SA(b, h) + aoff + m * 2048 + k * 1024); } while (0)
#define PG8_LDB(dst, b, h) do { _Pragma("unroll") for (int n = 0; n < 2; ++n) _Pragma("unroll") for (int k = 0; k < 2; ++k) dst[n][k] = *(const PG8_LAS bf16x8*)(lds + PG8_SB(b, h) + boff + n * 2048 + k * 1024); } while (0)
#define PG8_MMA(ai, bj, At, Bt) do { __builtin_amdgcn_s_setprio(1); _Pragma("unroll") for (int m = 0; m < 4; ++m) _Pragma("unroll") for (int n = 0; n < 2; ++n) _Pragma("unroll") for (int k = 0; k < 2; ++k) \
        acc[ai][bj][m][n] = __builtin_amdgcn_mfma_f32_16x16x32_bf16(Bt[n][k], At[m][k], acc[ai][bj][m][n], 0, 0, 0); __builtin_amdgcn_s_setprio(0); } while (0)
#define PG8_WAIT_V(n) asm volatile("s_waitcnt vmcnt(" #n ")" ::: "memory")
#define PG8_WAIT_L(n) asm volatile("s_waitcnt lgkmcnt(" #n ")" ::: "memory")
#define PG8_BAR __builtin_amdgcn_s_barrier()
#define PG8_SCHED __builtin_amdgcn_sched_barrier(0)
    Unit cur, nxt; int ui = 0;
    if (!S.next(0, cur)) return;
    f32x4 acc[2][2][4][2];
#pragma unroll
    for (int a = 0; a < 2; ++a)
#pragma unroll
        for (int b = 0; b < 2; ++b)
#pragma unroll
            for (int m = 0; m < 4; ++m)
#pragma unroll
                for (int n = 0; n < 2; ++n) acc[a][b][m][n] = (f32x4){0.f, 0.f, 0.f, 0.f};
    bf16x8 At[4][2], B0[2][2], B1[2][2];
    const char* cA = (const char*)g.A + (size_t)cur.pm * tstep; const char* cB = (const char*)g.Bt + (size_t)cur.pn * tstep;
    S.a_ready(cur);
    if constexpr (SP2) {
        PG8_STAGE(PG8_SB(0, 0), cB, voffB); PG8_STAGE(PG8_SB(0, 1), cB + hstep, voffB); PG8_STAGE(PG8_SA(0, 0), cA, voffA); PG8_STAGE(PG8_SA(0, 1), cA + hstep, voffA);
        if (wr == 1) PG8_BAR;
        PG8_WAIT_V(2); PG8_BAR;
        PG8_STAGE(PG8_SB(1, 0), cB + kstep, voffB); PG8_STAGE(PG8_SA(1, 0), cA + kstep, voffA); PG8_STAGE(PG8_SB(1, 1), cB + hstep + kstep, voffB);
        PG8_WAIT_V(6); PG8_BAR;
    } else {
        PG8_STAGE(PG8_SB(0, 0), cB, voffB); PG8_STAGE(PG8_SA(0, 0), cA, voffA); PG8_STAGE(PG8_SB(0, 1), cB + hstep, voffB); PG8_STAGE(PG8_SA(0, 1), cA + hstep, voffA);
        if (wr == 1) PG8_BAR;
        PG8_WAIT_V(4); PG8_BAR;
        PG8_STAGE(PG8_SB(1, 0), cB + kstep, voffB); PG8_STAGE(PG8_SA(1, 0), cA + kstep, voffA); PG8_STAGE(PG8_SB(1, 1), cB + hstep + kstep, voffB);
        PG8_WAIT_V(6); PG8_BAR;
    }
    for (;;) {
        const bool has_next = S.next(ui + 1, nxt);
        const char* nA = has_next ? (const char*)g.A + (size_t)nxt.pm * tstep : cA; const char* nB = has_next ? (const char*)g.Bt + (size_t)nxt.pn * tstep : cB;
        for (int t = 0; t < nt; t += 2) {
            const bool last = (t == nt - 2);
            const char* a1 = cA + (size_t)(t + 1) * kstep;
            const char* a2 = last ? nA : cA + (size_t)(t + 2) * kstep; const char* b2 = last ? nB : cB + (size_t)(t + 2) * kstep;
            const char* a3 = a2 + kstep; const char* b3 = b2 + kstep;
            if (last && has_next) S.a_ready(nxt);
            if constexpr (SP2) {
            PG8_LDB(B0, 0, 0); PG8_LDB(B1, 0, 1); PG8_SCHED; PG8_LDA(At, 0, 0); PG8_STAGE(PG8_SA(1, 1), a1 + hstep, voffA);
            PG8_WAIT_V(8); PG8_WAIT_L(0); PG8_BAR; PG8_MMA(0, 0, At, B0); PG8_MMA(0, 1, At, B1); PG8_BAR; PG8_SCHED;
            PG8_LDA(At, 0, 1); PG8_STAGE(PG8_SB(0, 0), b2, voffB); PG8_STAGE(PG8_SB(0, 1), b2 + hstep, voffB); PG8_STAGE(PG8_SA(0, 0), a2, voffA);
            PG8_WAIT_V(8); PG8_WAIT_L(0); PG8_BAR; PG8_MMA(1, 0, At, B0); PG8_MMA(1, 1, At, B1); PG8_BAR; PG8_SCHED;
            PG8_LDB(B0, 1, 0); PG8_LDB(B1, 1, 1); PG8_SCHED; PG8_LDA(At, 1, 0); PG8_STAGE(PG8_SA(0, 1), a2 + hstep, voffA);
            PG8_WAIT_V(8); PG8_WAIT_L(0); PG8_BAR; PG8_MMA(0, 0, At, B0); PG8_MMA(0, 1, At, B1); PG8_BAR; PG8_SCHED;
            PG8_LDA(At, 1, 1); PG8_STAGE(PG8_SB(1, 0), b3, voffB); PG8_STAGE(PG8_SB(1, 1), b3 + hstep, voffB); PG8_STAGE(PG8_SA(1, 0), a3, voffA);
            PG8_WAIT_V(8); PG8_WAIT_L(0); PG8_BAR; PG8_MMA(1, 0, At, B0); PG8_MMA(1, 1, At, B1); PG8_BAR; PG8_SCHED;
            } else {
            PG8_LDB(B0, 0, 0); PG8_SCHED; PG8_LDA(At, 0, 0); PG8_STAGE(PG8_SA(1, 1), a1 + hstep, voffA);
            PG8_WAIT_L(8); PG8_BAR; PG8_WAIT_L(0); PG8_MMA(0, 0, At, B0); PG8_BAR; PG8_SCHED;
            PG8_LDB(B1, 0, 1); PG8_STAGE(PG8_SB(0, 0), b2, voffB);
            PG8_BAR; PG8_WAIT_L(0); PG8_MMA(0, 1, At, B1); PG8_BAR;
            PG8_LDA(At, 0, 1); PG8_STAGE(PG8_SA(0, 0), a2, voffA);
            PG8_BAR; PG8_WAIT_L(0); PG8_MMA(1, 0, At, B0); PG8_BAR; PG8_SCHED;
            PG8_STAGE(PG8_SB(0, 1), b2 + hstep, voffB);
            PG8_WAIT_V(6); PG8_BAR; PG8_MMA(1, 1, At, B1); PG8_BAR;
            PG8_LDB(B0, 1, 0); PG8_SCHED; PG8_LDA(At, 1, 0); PG8_STAGE(PG8_SA(0, 1), a2 + hstep, voffA);
            PG8_WAIT_L(8); PG8_BAR; PG8_WAIT_L(0); PG8_MMA(0, 0, At, B0); PG8_BAR; PG8_SCHED;
            PG8_LDB(B1, 1, 1); PG8_STAGE(PG8_SB(1, 0), b3, voffB);
            PG8_BAR; PG8_WAIT_L(0); PG8_MMA(0, 1, At, B1); PG8_BAR;
            PG8_LDA(At, 1, 1); PG8_STAGE(PG8_SA(1, 0), a3, voffA);
            PG8_BAR; PG8_WAIT_L(0); PG8_MMA(1, 0, At, B0); PG8_BAR; PG8_SCHED;
            PG8_STAGE(PG8_SB(1, 1), b3 + hstep, voffB);
            PG8_WAIT_V(6); PG8_BAR; PG8_MMA(1, 1, At, B1); PG8_BAR;
            }
        }
        if constexpr (ALIGN_EPI) { if (wr == 0) PG8_BAR; }
        if constexpr (!Epi::AFTER_DRAIN) { E(acc, cur, wr, wc, fr, fq); S.done(cur); }
        if (!has_next) break;
#pragma unroll
        for (int a = 0; a < 2; ++a)
#pragma unroll
            for (int b = 0; b < 2; ++b)
#pragma unroll
                for (int m = 0; m < 4; ++m)
#pragma unroll
                    for (int n = 0; n < 2; ++n) acc[a][b][m][n] = (f32x4){0.f, 0.f, 0.f, 0.f};
        cur = nxt; cA = nA; cB = nB; ++ui;
        if constexpr (ALIGN_EPI) { if (wr == 1) PG8_BAR; }
    }
    PG8_WAIT_V(0);
    if constexpr (!ALIGN_EPI) { if (wr == 0) PG8_BAR; }
    PG8_BAR;
    if constexpr (Epi::AFTER_DRAIN) { E.fused(acc, cur, wr, wc, fr, fq, lds, wid, lane); S.done(cur); }
#undef PG8_SA
#undef PG8_SB
#undef PG8_STAGE
#undef PG8_LDA
#undef PG8_LDB
#undef PG8_MMA
#undef PG8_WAIT_V
#undef PG8_WAIT_L
#undef PG8_BAR
#undef PG8_SCHED
}
}

#define LAS __attribute__((address_space(3)))
typedef unsigned short bf16_t;
typedef short bf16x8 __attribute__((ext_vector_type(8)));
typedef short s16x4 __attribute__((ext_vector_type(4)));
typedef float f32x4 __attribute__((ext_vector_type(4)));
typedef float f32x16 __attribute__((ext_vector_type(16)));
typedef unsigned u32x4 __attribute__((ext_vector_type(4)));
typedef unsigned u32x2 __attribute__((ext_vector_type(2)));
typedef float f32x2_t __attribute__((ext_vector_type(2)));
typedef __bf16 bf16x2_t __attribute__((ext_vector_type(2)));
typedef LAS unsigned char* lptr;
#define BAR_LDS() asm volatile("s_waitcnt lgkmcnt(0)\n\ts_barrier" ::: "memory")
#define MFMA32(a, b, c) __builtin_amdgcn_mfma_f32_32x32x16_bf16((a), (b), (c), 0, 0, 0)

constexpr int BATCH = 4, SEQ = 4096, DM = 1024, DFF = 2816, M = BATCH * SEQ;
constexpr float RMS_EPS = 1e-6f, LOG2E = 1.4426950408889634f;
constexpr size_t MiB = 1u << 20;
constexpr size_t WS_WGU1 = 0, WS_WD1 = 11534336, WS_WIN = 17301504, WS_WOUT = 25690112, WS_WGU2 = 27787264, WS_WD2 = 39321600;
constexpr size_t WS_H = 48 * MiB, WS_AB = 80 * MiB, WS_CD = 81 * MiB, WS_BAR = 81 * MiB + 512 * 1024, WS_R1 = 82 * MiB, WS_R2 = 210 * MiB;
constexpr size_t WS_HID = WS_R2, WS_WG = WS_R2, WS_QD = WS_R2 + 32 * MiB, WS_KDT = WS_R2 + 64 * MiB, WS_AQK = WS_R2 + 96 * MiB, WS_U = WS_R2 + 112 * MiB, WS_END = WS_R2 + 176 * MiB;
constexpr size_t WS_XB = WS_R2 + 96 * MiB;
constexpr size_t WS_SS = 44 * MiB;
constexpr int LDS_BYTES = 147456;

__device__ __forceinline__ unsigned pk2(float lo, float hi) { f32x2_t v = {lo, hi}; bf16x2_t b = __builtin_convertvector(v, bf16x2_t); return __builtin_bit_cast(unsigned, b); }
__device__ __forceinline__ float bf_lo(unsigned u) { return __uint_as_float(u << 16); }
__device__ __forceinline__ float bf_hi(unsigned u) { return __uint_as_float(u & 0xffff0000u); }
template <int CTRL> __device__ __forceinline__ float dpp_f(float v) { return __uint_as_float((unsigned)__builtin_amdgcn_update_dpp(0, (int)__float_as_uint(v), CTRL, 0xf, 0xf, false)); }
__device__ __forceinline__ float row16_sum(float v) { v += dpp_f<0x128>(v); v += dpp_f<0x124>(v); v += dpp_f<0x122>(v); v += dpp_f<0x121>(v); return v; }
__device__ __forceinline__ float x16_sum(float v) { auto rr = __builtin_amdgcn_permlane16_swap(__float_as_uint(v), __float_as_uint(v), false, false); return __uint_as_float(rr[0]) + __uint_as_float(rr[1]); }
__device__ __forceinline__ float x32_sum(float v) { auto rr = __builtin_amdgcn_permlane32_swap(__float_as_uint(v), __float_as_uint(v), false, false); return __uint_as_float(rr[0]) + __uint_as_float(rr[1]); }
__device__ __forceinline__ float x32_max(float v) { auto rr = __builtin_amdgcn_permlane32_swap(__float_as_uint(v), __float_as_uint(v), false, false); return fmaxf(__uint_as_float(rr[0]), __uint_as_float(rr[1])); }
__device__ __forceinline__ float x32_other(float v, int hi) { auto rr = __builtin_amdgcn_permlane32_swap(__float_as_uint(v), __float_as_uint(v), false, false); return __uint_as_float(hi ? rr[0] : rr[1]); }
__device__ __forceinline__ float wave_sum(float v) { return x32_sum(x16_sum(row16_sum(v))); }
__device__ __forceinline__ int crow(int r, int hi) { return (r & 3) + 8 * (r >> 2) + 4 * hi; }
__device__ __forceinline__ float fast_exp2(float x) { return __builtin_amdgcn_exp2f(x); }
__device__ __forceinline__ float fast_log2(float x) { return __builtin_amdgcn_logf(x); }
__device__ __forceinline__ float fexp(float x) { return __builtin_amdgcn_exp2f(x * LOG2E); }
__device__ __forceinline__ float silu_f(float g) { return g * __builtin_amdgcn_rcpf(1.0f + __expf(-g)); }

__device__ __forceinline__ float row_rstd(const float* ss, int row) {
    const f32x4* q = (const f32x4*)(ss + (size_t)row * 16); const f32x4 a = q[0], b = q[1], c = q[2], d = q[3];
    const float t = ((a[0] + a[1]) + (a[2] + a[3])) + ((b[0] + b[1]) + (b[2] + b[3])) + ((c[0] + c[1]) + (c[2] + c[3])) + ((d[0] + d[1]) + (d[2] + d[3]));
    return rsqrtf(t * (1.f / DM) + RMS_EPS);
}
extern __shared__ __attribute__((aligned(16))) unsigned char lds_raw[];
constexpr int RS_TAB_OFF = 132096, RS_PM_OFF = 136192;
__device__ __forceinline__ const LAS float* rstd_table(const float* ss, int pm, int wr, int wc, int lane) {
    const lptr l0 = (lptr)lds_raw;
    const int wave = wr * 4 + wc;
    LAS float* tab = (LAS float*)(l0 + RS_TAB_OFF + wave * 512);
    LAS int* cpm = (LAS int*)(l0 + RS_PM_OFF + wave * 4);
    if (cpm[0] != pm) {
        tab[lane] = row_rstd(ss, pm * 256 + wr * 64 + lane);
        tab[64 + lane] = row_rstd(ss, pm * 256 + 128 + wr * 64 + lane);
        if (lane == 0) cpm[0] = pm;
        asm volatile("s_waitcnt lgkmcnt(0)" ::: "memory");
    }
    return tab;
}
struct EpiSwiGLU {
    static constexpr bool PERM = true, AFTER_DRAIN = false;
    bf16_t* O; int ldc; const float* ss;
    __device__ __forceinline__ void operator()(const pg8::f32x4 (&acc)[2][2][4][2], const pg8::Unit& u, int wr, int wc, int fr, int fq) const {
        const int row0 = u.pm * 256 + wr * 64 + fr, col0 = u.pn * 128 + wc * 32 + 8 * fq;
        const LAS float* tab = rstd_table(ss, u.pm, wr, wc, fr + 16 * fq);
#pragma unroll
        for (int ai = 0; ai < 2; ++ai)
#pragma unroll
            for (int m = 0; m < 4; ++m) {
                const int row = row0 + ai * 128 + m * 16;
                const float rs = tab[64 * ai + 16 * m + fr];
                bf16_t* rowp = O + (size_t)row * ldc + col0;
                const pg8::f32x4 g0 = acc[ai][0][m][0] * rs, g1 = acc[ai][0][m][1] * rs, u0 = acc[ai][1][m][0] * rs, u1 = acc[ai][1][m][1] * rs;
                u32x4 w;
                w.x = pk2(silu_f(g0[0]) * u0[0], silu_f(g0[1]) * u0[1]); w.y = pk2(silu_f(g0[2]) * u0[2], silu_f(g0[3]) * u0[3]);
                w.z = pk2(silu_f(g1[0]) * u1[0], silu_f(g1[1]) * u1[1]); w.w = pk2(silu_f(g1[2]) * u1[2], silu_f(g1[3]) * u1[3]);
                *(u32x4*)rowp = w;
            }
    }
};
template <bool HALF> struct EpiResid {
    static constexpr bool PERM = true, AFTER_DRAIN = false;
    static constexpr float s = HALF ? 0.5f : 1.0f;
    bf16_t* xb; float* ssn;
    __device__ __forceinline__ void operator()(const pg8::f32x4 (&acc)[2][2][4][2], const pg8::Unit& u, int wr, int wc, int fr, int fq) const {
        const int row0 = u.pm * 256 + wr * 64 + fr, col0 = u.pn * 256 + wc * 32 + 8 * fq;
#pragma unroll
        for (int ai = 0; ai < 2; ++ai)
#pragma unroll
            for (int m = 0; m < 4; ++m) {
                const int row = row0 + ai * 128 + m * 16;
                bf16_t* rowp = xb + (size_t)row * DM + col0;
                float q = 0.f;
#pragma unroll
                for (int bj = 0; bj < 2; ++bj) {
                    const u32x4 bb = *(const u32x4*)(rowp + bj * 128);
                    const pg8::f32x4 b0 = {bf_lo(bb.x), bf_hi(bb.x), bf_lo(bb.y), bf_hi(bb.y)}, b1 = {bf_lo(bb.z), bf_hi(bb.z), bf_lo(bb.w), bf_hi(bb.w)};
                    const pg8::f32x4 v0 = b0 + acc[ai][bj][m][0] * s, v1 = b1 + acc[ai][bj][m][1] * s;
                    u32x4 w; w.x = pk2(v0[0], v0[1]); w.y = pk2(v0[2], v0[3]); w.z = pk2(v1[0], v1[1]); w.w = pk2(v1[2], v1[3]);
                    *(u32x4*)(rowp + bj * 128) = w;
                    q += ((v0[0] * v0[0] + v0[1] * v0[1]) + (v0[2] * v0[2] + v0[3] * v0[3])) + ((v1[0] * v1[0] + v1[1] * v1[1]) + (v1[2] * v1[2] + v1[3] * v1[3]));
                }
                q = x32_sum(x16_sum(q));
                if (fq == 0) ssn[(size_t)row * 16 + u.pn * 4 + wc] = q;
            }
    }
};
struct EpiBf16 {
    static constexpr bool PERM = true, AFTER_DRAIN = false;
    bf16_t* O; int ldc; const float* ss;
    __device__ __forceinline__ void operator()(const pg8::f32x4 (&acc)[2][2][4][2], const pg8::Unit& u, int wr, int wc, int fr, int fq) const {
        const int row0 = u.pm * 256 + wr * 64 + fr, col0 = u.pn * 256 + wc * 32 + 8 * fq;
        const LAS float* tab = rstd_table(ss, u.pm, wr, wc, fr + 16 * fq);
#pragma unroll
        for (int ai = 0; ai < 2; ++ai)
#pragma unroll
            for (int m = 0; m < 4; ++m) {
                const int row = row0 + ai * 128 + m * 16;
                const float rs = tab[64 * ai + 16 * m + fr];
                bf16_t* rowp = O + (size_t)row * ldc + col0;
#pragma unroll
                for (int bj = 0; bj < 2; ++bj) {
                    const pg8::f32x4 v0 = acc[ai][bj][m][0] * rs, v1 = acc[ai][bj][m][1] * rs;
                    u32x4 w; w.x = pk2(v0[0], v0[1]); w.y = pk2(v0[2], v0[3]); w.z = pk2(v1[0], v1[1]); w.w = pk2(v1[2], v1[3]);
                    *(u32x4*)(rowp + bj * 128) = w;
                }
            }
    }
};
template <class Epi>
__device__ __forceinline__ void run_gemm(lptr lds, const bf16_t* A, const bf16_t* Bt, int N, int K, const Epi& E) {
    { const int t_ = opaque_tid(); if ((t_ & 63) == 0) *(LAS int*)(lds + RS_PM_OFF + (t_ >> 6) * 4) = -1; }
    pg8::Gemm g{A, Bt, M, N, K}; pg8::StaticOrder S; S.init(M, N, (int)gridDim.x, (int)blockIdx.x);
    pg8::gemm_phase<Epi, pg8::StaticOrder, true, true>(lds, g, S, E);
}

__device__ __forceinline__ void tr_item(const float* W, int ldw, int k0, int n0, bf16_t* WT, int K, int drow0, LAS float* scr, int lane, const float* nw) {
    float tv[32];
#pragma unroll
    for (int i = 0; i < 32; ++i) tv[i] = W[(size_t)(k0 + 2 * i + (lane >> 5)) * ldw + n0 + (lane & 31)];
#pragma unroll
    for (int i = 0; i < 32; ++i) scr[(2 * i + (lane >> 5)) * 33 + (lane & 31)] = nw ? tv[i] * nw[k0 + 2 * i + (lane >> 5)] : tv[i];
    asm volatile("s_waitcnt lgkmcnt(0)" ::: "memory");
    const int c = lane & 7;
#pragma unroll
    for (int j = 0; j < 4; ++j) {
        const int n = (lane >> 3) + 8 * j; const LAS float* s = scr + (8 * c) * 33 + n;
        u32x4 o; o.x = pk2(s[0 * 33], s[1 * 33]); o.y = pk2(s[2 * 33], s[3 * 33]); o.z = pk2(s[4 * 33], s[5 * 33]); o.w = pk2(s[6 * 33], s[7 * 33]);
        *(u32x4*)(WT + (size_t)(drow0 + n) * K + k0 + 8 * c) = o;
    }
    asm volatile("s_waitcnt lgkmcnt(0)" ::: "memory");
}
struct Params { const float* in[21]; float* out; unsigned char* ws; };

__device__ __forceinline__ void convert_layer(const Params& p, int l, lptr lds, int part, int b0) {
    const int tid = opaque_tid(), lane = tid & 63, wave = tid >> 6;
    LAS float* scr = (LAS float*)(lds + wave * 16384);
    const int gw = ((int)blockIdx.x - b0) * 8 + wave, NGW = ((int)gridDim.x - b0) * 8;
    const bool odd = l & 1; const int e = l >> 1;
    const float* Win = odd ? p.in[10] + (size_t)e * DM * 4112 : p.in[6] + (size_t)e * DM * 3072;
    const int ldin = odd ? 4112 : 3072, nin = odd ? 4096 : 3072;
    const float* Wout = odd ? p.in[15] + (size_t)e * DM * DM : p.in[9] + (size_t)e * DM * DM;
    const int I_G = (DM / 64) * (DFF / 32), I_D = (DFF / 64) * (DM / 32), I_IN = (DM / 64) * (nin / 32), I_OUT = (DM / 64) * (DM / 32);
    const int n1 = 2 * I_G + I_D, total = 4 * I_G + 2 * I_D + I_IN + I_OUT;
    for (int it = (part == 1 ? 0 : n1) + gw; it < (part == 1 ? n1 : total); it += NGW) {
        int r = it;
#define SEG(Wp, LDW, KK, NITEMS, NBLK, WTOFF, MODE, NW) \
        if (r < (NITEMS)) { const int kb = r / (NBLK), nb = r % (NBLK); const int n0 = 32 * nb; \
            const int dr = (MODE) == 0 ? n0 : ((n0 >> 7) * 256 + (n0 & 127) + ((MODE) == 2 ? 128 : 0)); \
            tr_item((Wp), (LDW), 64 * kb, n0, (bf16_t*)(p.ws + (WTOFF)), (KK), dr, scr, lane, (NW)); continue; } r -= (NITEMS);
        SEG(p.in[2] + (size_t)l * DM * DFF, DFF, DM, I_G, DFF / 32, WS_WGU1, 1, p.in[1] + (size_t)l * DM)
        SEG(p.in[3] + (size_t)l * DM * DFF, DFF, DM, I_G, DFF / 32, WS_WGU1, 2, p.in[1] + (size_t)l * DM)
        SEG(p.in[4] + (size_t)l * DM * DFF, DM, DFF, I_D, DM / 32, WS_WD1, 0, (const float*)nullptr)
        if (odd) { SEG(Win, 4112, DM, 2048, 128, WS_WIN, 0, p.in[5] + (size_t)l * DM) } else { SEG(Win, 3072, DM, 1536, 96, WS_WIN, 0, p.in[5] + (size_t)l * DM) }
        SEG(Wout, DM, DM, I_OUT, DM / 32, WS_WOUT, 0, (const float*)nullptr)
        SEG(p.in[17] + (size_t)l * DM * DFF, DFF, DM, I_G, DFF / 32, WS_WGU2, 1, p.in[16] + (size_t)l * DM)
        SEG(p.in[18] + (size_t)l * DM * DFF, DFF, DM, I_G, DFF / 32, WS_WGU2, 2, p.in[16] + (size_t)l * DM)
        SEG(p.in[19] + (size_t)l * DM * DFF, DM, DFF, I_D, DM / 32, WS_WD2, 0, (const float*)nullptr)
#undef SEG
    }
}

__device__ __forceinline__ void prologue_phase(const float* X, bf16_t* XB, float* ss) {
    const int tid = opaque_tid(), lane = tid & 63, wave = tid >> 6;
    const int gw = blockIdx.x * 8 + wave, NGW = gridDim.x * 8;
    for (int m = gw; m < M; m += NGW) {
        const f32x4* xr = (const f32x4*)(X + (size_t)m * DM) + lane;
        f32x4 v[4]; float s = 0.f;
#pragma unroll
        for (int j = 0; j < 4; ++j) { v[j] = xr[64 * j]; s += (v[j][0] * v[j][0] + v[j][1] * v[j][1]) + (v[j][2] * v[j][2] + v[j][3] * v[j][3]); }
        s = wave_sum(s);
        u32x2* o8 = (u32x2*)(XB + (size_t)m * DM) + lane;
#pragma unroll
        for (int j = 0; j < 4; ++j) { u32x2 o; o.x = pk2(v[j][0], v[j][1]); o.y = pk2(v[j][2], v[j][3]); o8[64 * j] = o; }
        if (lane < 16) ss[(size_t)m * 16 + lane] = lane == 0 ? s : 0.f;
    }
}
__device__ __forceinline__ void ab_phase(const bf16_t* XBp, const float* w, const float* ss, const float* W16src, float* ABout, lptr lds) {
    const int tid = opaque_tid(), lane = tid & 63, wave = tid >> 6;
    const int gw = blockIdx.x * 8 + wave, NGW = gridDim.x * 8;
    LAS float* W16t = (LAS float*)lds;
    for (int k = tid; k < DM; k += 512) {
        const f32x4* src = (const f32x4*)(W16src + (size_t)k * 4112);
#pragma unroll
        for (int q = 0; q < 4; ++q) { const f32x4 v = src[q]; W16t[(4 * q + 0) * 1024 + k] = v[0]; W16t[(4 * q + 1) * 1024 + k] = v[1]; W16t[(4 * q + 2) * 1024 + k] = v[2]; W16t[(4 * q + 3) * 1024 + k] = v[3]; }
    }
    __syncthreads();
    f32x4 wv[4];
#pragma unroll
    for (int j = 0; j < 4; ++j) wv[j] = ((const f32x4*)w)[64 * j + lane];
    for (int m = gw; m < M; m += NGW) {
        const u32x2* xr = (const u32x2*)(XBp + (size_t)m * DM) + lane;
        const float rstd = row_rstd(ss, m);
        f32x4 v[4];
#pragma unroll
        for (int j = 0; j < 4; ++j) { const u32x2 t = xr[64 * j]; const f32x4 xv = {bf_lo(t.x), bf_hi(t.x), bf_lo(t.y), bf_hi(t.y)}; v[j] = xv * rstd * wv[j]; }
        float mine = 0.f;
#pragma nounroll
        for (int c = 0; c < 16; ++c) {
            float a = 0.f;
#pragma unroll
            for (int j = 0; j < 4; ++j) { const f32x4 t = *(const LAS f32x4*)(W16t + c * 1024 + 256 * j + 4 * lane); a += (v[j][0] * t[0] + v[j][1] * t[1]) + (v[j][2] * t[2] + v[j][3] * t[3]); }
            a = wave_sum(a);
            if (lane == c) mine = a;
        }
        if (lane < 16) ABout[(size_t)m * 16 + lane] = mine;
    }
    __syncthreads();
}
__device__ __forceinline__ void final_norm_phase(const bf16_t* XBp, float* out, const float* w) {
    const int tid = opaque_tid(), lane = tid & 63, wave = tid >> 6;
    const int gw = blockIdx.x * 8 + wave, NGW = gridDim.x * 8;
    f32x4 wv[4];
#pragma unroll
    for (int j = 0; j < 4; ++j) wv[j] = ((const f32x4*)w)[64 * j + lane];
    for (int m = gw; m < M; m += NGW) {
        const u32x2* xr = (const u32x2*)(XBp + (size_t)m * DM) + lane;
        f32x4* orow = (f32x4*)(out + (size_t)m * DM) + lane;
        f32x4 v[4]; float s = 0.f;
#pragma unroll
        for (int j = 0; j < 4; ++j) { const u32x2 t = xr[64 * j]; v[j] = (f32x4){bf_lo(t.x), bf_hi(t.x), bf_lo(t.y), bf_hi(t.y)}; s += (v[j][0] * v[j][0] + v[j][1] * v[j][1]) + (v[j][2] * v[j][2] + v[j][3] * v[j][3]); }
        const float rstd = rsqrtf(wave_sum(s) * (1.f / DM) + RMS_EPS);
#pragma unroll
        for (int j = 0; j < 4; ++j) orow[64 * j] = v[j] * rstd * wv[j];
    }
}

namespace att {
constexpr int PLD = 3072, KROWB = 272, VROWB = 136;
constexpr int SLOT = 64 * KROWB + 128 * VROWB;
constexpr int OFF_STAT = 2 * SLOT, OFF_X = OFF_STAT + 256;

template <int MODE>
__device__ __forceinline__ void unit(const bf16_t* P, bf16_t* AO, int b, int h, int qb, lptr sm, float lam, const float* subln, float lam_init) {
    const int tid = opaque_tid(), lane = tid & 63, wid = __builtin_amdgcn_readfirstlane(tid >> 6), r32 = lane & 31, hi = lane >> 5;
    constexpr int UROWS = MODE ? 256 : 128;
    const int comp = MODE ? 0 : (wid >> 2);
    const int q0 = qb * UROWS, tq0 = q0 + 32 * (MODE ? wid : (wid & 3)), tq = tq0 + r32;
    const size_t rowbase = (size_t)b * SEQ;
    const int qcol = MODE ? 1536 + h * 128 : h * 128 + 64 * comp;
    const int kcol = MODE ? 2048 + h * 128 : 512 + h * 128;
    const int vcol = MODE ? 2560 + h * 128 : 1024 + h * 128;
    constexpr int NJ = MODE ? 8 : 4;
    bf16x8 qf[NJ];
#pragma unroll
    for (int j = 0; j < NJ; ++j) qf[j] = *(const bf16x8*)(P + (rowbase + tq) * PLD + qcol + 16 * j + 8 * hi);
    const int nt = (q0 + UROWS) / 64;
    const int kt_d = tq0 >> 6, dsub = (tq0 >> 5) & 1;
    const int krow0 = tid >> 4, kseg = tid & 15;
    const int vo = 4 * (wid & 3) + (lane & 3), vp = 16 * (wid >> 2) + (lane >> 2);
    u32x4 kA0, kA1, vA0, vA1, kB0, kB1, vB0, vB1;
    const bf16_t* const kp0_ = P + (rowbase + krow0) * PLD + kcol + kseg * 8;
    const bf16_t* const vp0_ = P + (rowbase + 2 * vp) * PLD + vcol + 8 * vo;
#define ATT_LOAD(kt, K0, K1, V0, V1) do { const size_t to_ = (size_t)(kt) * (64 * PLD); \
        K0 = *(const u32x4*)(kp0_ + to_); K1 = *(const u32x4*)(kp0_ + to_ + 32 * PLD); \
        V0 = *(const u32x4*)(vp0_ + to_); V1 = *(const u32x4*)(vp0_ + to_ + PLD); } while (0)
#define ATT_STORE(slot, K0, K1, V0, V1) do { const lptr sb_ = sm + (slot) * SLOT; \
        *(LAS u32x4*)(sb_ + krow0 * KROWB + kseg * 16) = K0; *(LAS u32x4*)(sb_ + (krow0 + 32) * KROWB + kseg * 16) = K1; \
        _Pragma("unroll") for (int i = 0; i < 8; ++i) { \
            const unsigned w_ = __builtin_amdgcn_perm(V1[i >> 1], V0[i >> 1], (i & 1) ? 0x07060302u : 0x05040100u);     \
            *(LAS unsigned*)(sb_ + 64 * KROWB + (8 * vo + i) * VROWB + 4 * vp) = w_; } } while (0)
    LAS int* stat = (LAS int*)(sm + OFF_STAT);
    __syncthreads();
    if (tid < 16) stat[tid] = 0;
    if (MODE == 0) {
        ATT_LOAD(nt - 1, kB0, kB1, vB0, vB1);
        ATT_STORE(1, kB0, kB1, vB0, vB1);
        ATT_LOAD(nt - 2, kA0, kA1, vA0, vA1);
        ATT_LOAD(nt >= 4 ? nt - 3 : 0, kB0, kB1, vB0, vB1);
    } else {
        ATT_LOAD(nt - 1, kA0, kA1, vA0, vA1);
        ATT_STORE(1, kA0, kA1, vA0, vA1);
        ATT_LOAD(nt - 2, kA0, kA1, vA0, vA1);
    }
    f32x16 O[4];
#pragma unroll
    for (int i = 0; i < 4; ++i)
#pragma unroll
        for (int r = 0; r < 16; ++r) O[i][r] = 0.f;
    float mrun = -1e30f, lrun = 0.f, Crun = 0.f;
    bool wdone = false;
    const float slope2 = fast_exp2(-2.0f * (float)(h + 1)) * LOG2E;
    const float c1 = (MODE ? 0.08838834764831845f : 0.125f) * LOG2E;
    const float slc = slope2 / c1;
    if (wid >= 4) __builtin_amdgcn_s_setprio(1);
    bool stop = false;
#define ATT_HEAD(kt, K0, K1, V0, V1) \
        BAR_LDS();                            \
        int doneall = 0; \
        if (MODE) { const LAS int* st = stat + 8 * (((kt) + 1) & 1); doneall = (st[0] + st[1]) + (st[2] + st[3]) + (st[4] + st[5]) + (st[6] + st[7]); } \
        if (MODE == 0) { ATT_STORE(((kt) - 1) & 1, K0, K1, V0, V1); ATT_LOAD((kt) > 3 ? (kt) - 3 : 0, K0, K1, V0, V1); }     \
        else if ((kt) > 0) { ATT_STORE(((kt) - 1) & 1, K0, K1, V0, V1); if ((kt) > 1) ATT_LOAD((kt) - 2, K0, K1, V0, V1); }
    for (int kt2 = nt - 1; kt2 >= 0 && !stop; kt2 -= 2)
#pragma unroll
    for (int half = 0; half < 2; ++half) {
        const int kt = kt2 - half;
        if (stop) continue;
        int doneall_;
        if (half == 0 || MODE == 1) { ATT_HEAD(kt, kA0, kA1, vA0, vA1) doneall_ = doneall; }
        else { ATT_HEAD(kt, kB0, kB1, vB0, vB1) doneall_ = doneall; }
        const int doneall = doneall_;
        if (MODE && doneall == 8) { stop = true; continue; }
        const lptr Ks = sm + (kt & 1) * SLOT, Vs = Ks + 64 * KROWB;
        if (kt <= kt_d && !wdone) {
        if (MODE == 0) {
            f32x16 s[2];
            const bool diag = (kt == kt_d);
            const float bias0 = diag ? 0.f : slc * (float)(kt * 64 + 4 * hi);
            const float slc0 = diag ? 0.f : slc;
#pragma unroll
            for (int sub = 0; sub < 2; ++sub) {
#pragma unroll
                for (int r = 0; r < 16; ++r) s[sub][r] = __builtin_fmaf(slc0, (float)(32 * sub + (r & 3) + 8 * (r >> 2)), bias0);
#pragma unroll
                for (int j = 0; j < 4; ++j) {
                    const bf16x8 kf = *(const LAS bf16x8*)(Ks + (32 * sub + r32) * KROWB + (64 * comp + 16 * j + 8 * hi) * 2);
                    s[sub] = MFMA32(kf, qf[j], s[sub]);
                }
            }
            if (diag) {
#pragma unroll
                for (int sub = 0; sub < 2; ++sub)
#pragma unroll
                    for (int r = 0; r < 16; ++r) {
                        const int kv = kt * 64 + 32 * sub + crow(r, hi);
                        s[sub][r] += slc * ((float)tq - fabsf((float)(tq - kv)));
                    }
            }
            float mx = -1e30f;
#pragma unroll
            for (int sub = 0; sub < 2; ++sub)
#pragma unroll
                for (int r = 0; r < 16; r += 2) mx = __builtin_fmaxf(__builtin_fmaxf(mx, s[sub][r]), s[sub][r + 1]);
            mx = x32_max(mx);
            if (!__all((mx - mrun) * c1 < -150.0f)) {
            const float mnew = fmaxf(mrun, mx);
            const float f = fast_exp2((mrun - mnew) * c1);
            mrun = mnew; lrun *= f;
            if (__any(f != 1.0f)) {
#pragma unroll
                for (int i = 0; i < 4; ++i) O[i] = O[i] * f;
            }
            const float mc = -mnew * c1;
            bf16x8 pf[2][2];
            float ls = 0.f;
#pragma unroll
            for (int sub = 0; sub < 2; ++sub) {
#pragma unroll
                for (int r = 0; r < 16; ++r) { const float pv = fast_exp2(__builtin_fmaf(s[sub][r], c1, mc)); s[sub][r] = pv; ls += pv; }
#pragma unroll
                for (int s2 = 0; s2 < 2; ++s2) {
                    u32x4 w; w.x = pk2(s[sub][8 * s2 + 0], s[sub][8 * s2 + 1]); w.y = pk2(s[sub][8 * s2 + 2], s[sub][8 * s2 + 3]);
                    w.z = pk2(s[sub][8 * s2 + 4], s[sub][8 * s2 + 5]); w.w = pk2(s[sub][8 * s2 + 6], s[sub][8 * s2 + 7]);
                    pf[sub][s2] = __builtin_bit_cast(bf16x8, w);
                }
            }
            lrun += ls;
            {
#define VFRAG(blk_, q_) ({ const lptr vb_ = Vs + (32 * (blk_) + r32) * VROWB + 2 * (16 * (q_) + 4 * hi); const s16x4 lo_ = *(const LAS s16x4*)vb_, hi_ = *(const LAS s16x4*)(vb_ + 16); (bf16x8)__builtin_shufflevector(lo_, hi_, 0, 1, 2, 3, 4, 5, 6, 7); })
                bf16x8 vcur[4], vnxt[4];
#pragma unroll
                for (int q = 0; q < 4; ++q) vcur[q] = VFRAG(0, q);
#pragma unroll
                for (int blk = 0; blk < 4; ++blk) {
                    if (blk < 3) {
#pragma unroll
                        for (int q = 0; q < 4; ++q) vnxt[q] = VFRAG(blk + 1, q);
                    }
#pragma unroll
                    for (int q = 0; q < 4; ++q) O[blk] = MFMA32(vcur[q], pf[q >> 1][q & 1], O[blk]);
#pragma unroll
                    for (int q = 0; q < 4; ++q) vcur[q] = vnxt[q];
                }
#undef VFRAG
            }
            }
        } else {
#pragma unroll
            for (int subi = 0; subi < 2; ++subi) {
                const int sub = 1 - subi;
                if (kt == kt_d && sub > dsub) continue;
                const bool diag = (kt == kt_d && sub == dsub);
                f32x16 s;
#pragma unroll
                for (int r = 0; r < 16; ++r) s[r] = 0.f;
#pragma unroll
                for (int j = 0; j < 8; ++j) {
                    const bf16x8 kf = *(const LAS bf16x8*)(Ks + (32 * sub + r32) * KROWB + (16 * j + 8 * hi) * 2);
                    s = MFMA32(kf, qf[j], s);
                }
                const int kvbase = kt * 64 + 32 * sub;
                float lk[16], yl[16];
#pragma unroll
                for (int r = 0; r < 16; ++r) {
                    const float y = s[r] * c1;
                    const float e = fast_exp2(-fabsf(y));
                    const float L = fmaxf(y, 0.f) + fast_log2(1.0f + e);
                    const bool valid = !diag || (kvbase + crow(r, hi) < tq);
                    lk[r] = valid ? -L : 0.f;
                    yl[r] = valid ? (y - L) : -1e30f;
                }
                float gs[4], pgs[4];
#pragma unroll
                for (int g = 0; g < 4; ++g) { gs[g] = (lk[4 * g] + lk[4 * g + 1]) + (lk[4 * g + 2] + lk[4 * g + 3]); pgs[g] = x32_other(gs[g], hi); }
                const float T0 = gs[0] + pgs[0], T1 = gs[1] + pgs[1], T2 = gs[2] + pgs[2], T3 = gs[3] + pgs[3];
                float Sg[4]; Sg[3] = 0.f; Sg[2] = T3; Sg[1] = T3 + T2; Sg[0] = T3 + T2 + T1;
                float a[16];
#pragma unroll
                for (int g = 0; g < 4; ++g) {
                    float c = Crun + Sg[g] + (hi == 0 ? pgs[g] : 0.f);
                    a[4 * g + 3] = fast_exp2(yl[4 * g + 3] + c); c += lk[4 * g + 3];
                    a[4 * g + 2] = fast_exp2(yl[4 * g + 2] + c); c += lk[4 * g + 2];
                    a[4 * g + 1] = fast_exp2(yl[4 * g + 1] + c); c += lk[4 * g + 1];
                    a[4 * g + 0] = fast_exp2(yl[4 * g + 0] + c);
                }
                Crun += Sg[0] + T0;
                bf16x8 pf[2];
#pragma unroll
                for (int s2 = 0; s2 < 2; ++s2) {
                    u32x4 w; w.x = pk2(a[8 * s2 + 0], a[8 * s2 + 1]); w.y = pk2(a[8 * s2 + 2], a[8 * s2 + 3]);
                    w.z = pk2(a[8 * s2 + 4], a[8 * s2 + 5]); w.w = pk2(a[8 * s2 + 6], a[8 * s2 + 7]);
                    pf[s2] = __builtin_bit_cast(bf16x8, w);
                }
                {
#define VFRAG(blk_, s2_) ({ const lptr vb_ = Vs + (32 * (blk_) + r32) * VROWB + 2 * (32 * sub + 16 * (s2_) + 4 * hi); const s16x4 lo_ = *(const LAS s16x4*)vb_, hi_ = *(const LAS s16x4*)(vb_ + 16); (bf16x8)__builtin_shufflevector(lo_, hi_, 0, 1, 2, 3, 4, 5, 6, 7); })
                    bf16x8 vcur[2], vnxt[2];
                    vcur[0] = VFRAG(0, 0); vcur[1] = VFRAG(0, 1);
#pragma unroll
                    for (int blk = 0; blk < 4; ++blk) {
                        if (blk < 3) { vnxt[0] = VFRAG(blk + 1, 0); vnxt[1] = VFRAG(blk + 1, 1); }
                        O[blk] = MFMA32(vcur[0], pf[0], O[blk]); O[blk] = MFMA32(vcur[1], pf[1], O[blk]);
                        vcur[0] = vnxt[0]; vcur[1] = vnxt[1];
                    }
#undef VFRAG
                }
            }
            if (__all(Crun < -160.0f)) wdone = true;
        }
        }
        if (MODE) { if (lane == 0) stat[8 * (kt & 1) + wid] = wdone ? 1 : 0; }
    }
#undef ATT_STORE
#undef ATT_HEAD
    __builtin_amdgcn_s_setprio(0);
#undef ATT_LOAD
    if (MODE == 1) {
        bf16_t* orow = AO + (rowbase + tq) * DM + 512 + h * 128;
#pragma unroll
        for (int blk = 0; blk < 4; ++blk)
#pragma unroll
            for (int g = 0; g < 4; ++g) {
                u32x2 w; w.x = pk2(O[blk][4 * g], O[blk][4 * g + 1]); w.y = pk2(O[blk][4 * g + 2], O[blk][4 * g + 3]);
                *(u32x2*)(orow + 32 * blk + 8 * g + 4 * hi) = w;
            }
    } else {
        const float ltot = x32_sum(lrun);
        const float inv = 1.0f / ltot;
        LAS float* X = (LAS float*)(sm + OFF_X);
        if (wid >= 4) {
#pragma unroll
            for (int blk = 0; blk < 4; ++blk)
#pragma unroll
                for (int r = 0; r < 16; ++r) X[(((wid - 4) * 64 + blk * 16 + r) << 6) + lane] = O[blk][r] * inv;
        }
        __syncthreads();
        if (wid < 4) {
            float ss = 0.f;
#pragma unroll
            for (int blk = 0; blk < 4; ++blk)
#pragma unroll
                for (int r = 0; r < 16; ++r) { const float o = O[blk][r] * inv - lam * X[((wid * 64 + blk * 16 + r) << 6) + lane]; O[blk][r] = o; ss += o * o; }
            ss = x32_sum(ss);
            const float rs = rsqrtf(ss * (1.0f / 128.0f) + RMS_EPS) * (1.0f - lam_init);
            bf16_t* orow = AO + (rowbase + tq) * DM + h * 128;
#pragma unroll
            for (int blk = 0; blk < 4; ++blk)
#pragma unroll
                for (int g = 0; g < 4; ++g) {
                    const int dv = 32 * blk + 8 * g + 4 * hi;
                    const f32x4 wv = *(const f32x4*)(subln + dv);
                    u32x2 w; w.x = pk2(O[blk][4 * g] * rs * wv[0], O[blk][4 * g + 1] * rs * wv[1]); w.y = pk2(O[blk][4 * g + 2] * rs * wv[2], O[blk][4 * g + 3] * rs * wv[3]);
                    *(u32x2*)(orow + dv) = w;
                }
        }
    }
}

__device__ __forceinline__ void phase(const bf16_t* P, bf16_t* AO, const float* lamp, const float* subln, int layer, unsigned* ctr, lptr sm) {
    asm volatile("" : "+s"(layer));
    const float lam_init = 0.8f - 0.6f * expf(-0.3f * (float)layer);
    float d1 = 0.f, d2 = 0.f;
    for (int i = 0; i < 64; ++i) { d1 += lamp[i] * lamp[64 + i]; d2 += lamp[128 + i] * lamp[192 + i]; }
    const float lam = expf(d1) - expf(d2) + lam_init;
    LAS int* nxt = (LAS int*)(sm + OFF_STAT + 128);
    for (;;) {
        __syncthreads();
        if (threadIdx.x == 0) nxt[0] = (int)__hip_atomic_fetch_add(ctr, 1u, __ATOMIC_RELAXED, __HIP_MEMORY_SCOPE_AGENT);
        __syncthreads();
        const int u = nxt[0];
        if (u >= 768) break;
        if (u < 512) {
            const int hh = 3 - (u >> 7), v = u & 127;
            unit<0>(P, AO, v & 3, hh, 31 - (v >> 2), sm, lam, subln, lam_init);
        } else {
            const int w = u - 512, bh = w & 15;
            unit<1>(P, AO, bh >> 2, bh & 3, 15 - (w >> 4), sm, lam, subln, lam_init);
        }
    }
}
}

namespace gdn {
constexpr int PLD = 4096;
constexpr int RB = 272, TB = 144;
constexpr int OFF_QS = 0, OFF_KS = 64 * RB, OFF_KBT = OFF_KS + 64 * RB, OFF_VBT = OFF_KBT + 128 * TB, OFF_LF = OFF_VBT + 128 * TB, OFF_TF = OFF_LF + 64 * 65 * 4,
              OFF_MF = OFF_TF + 64 * 68 * 4, OFF_TBF = OFF_MF + 16 * 68 * 4, OFF_GC = OFF_TBF + 64 * TB, OFF_BETA = OFF_GC + 256, OFF_END = OFF_BETA + 256;
static_assert(OFF_END <= 131072, "gdn LDS");

__device__ __forceinline__ void chunk_phase(const bf16_t* P, const float* ABv, const float* convw, const float* alog, const float* dtb, unsigned char* ws, lptr sm) {
    const int tid = opaque_tid(), lane = tid & 63, wid = __builtin_amdgcn_readfirstlane(tid >> 6), r32 = lane & 31, hi = lane >> 5;
    LAS float* gcs = (LAS float*)(sm + OFF_GC); LAS float* betas = (LAS float*)(sm + OFF_BETA);
    LAS float* Lf = (LAS float*)(sm + OFF_LF); LAS float* Tf = (LAS float*)(sm + OFF_TF); LAS float* Mf = (LAS float*)(sm + OFF_MF);
    const int part = tid >> 7, o = tid & 15, tg = (tid & 127) >> 4;
    u32x4 xr[11]; float braw = 0.f, araw = 0.f;
#define CHUNK_PREFETCH(unx) do { const int n_ = (unx) & 63, h_ = ((unx) >> 6) & 7, b_ = (unx) >> 9; \
        if (part < 3) { const int ch_ = part * 1024 + h_ * 128 + 8 * o; \
            _Pragma("unroll") for (int rr = 0; rr < 11; ++rr) { const int sp = n_ * 64 + 8 * tg + rr - 3; \
                if (sp >= 0) xr[rr] = *(const u32x4*)(P + ((size_t)b_ * SEQ + sp) * PLD + ch_); else xr[rr] = (u32x4){0u, 0u, 0u, 0u}; } \
            } \
        if (tid < 64) { const size_t t_ = (size_t)b_ * SEQ + (size_t)n_ * 64 + tid; braw = ABv[t_ * 16 + h_]; araw = ABv[t_ * 16 + 8 + h_]; } } while (0)
    if ((int)blockIdx.x < 2048) CHUNK_PREFETCH((int)blockIdx.x);
#pragma nounroll
    for (int un = blockIdx.x; un < 2048; un += gridDim.x) {
    int tid_l = tid; asm volatile("" : "+v"(tid_l));
    const int tid = tid_l, lane = tid & 63, wid = __builtin_amdgcn_readfirstlane(tid >> 6), r32 = lane & 31, hi = lane >> 5;
    const int part = tid >> 7, o = tid & 15, tg = (tid & 127) >> 4;
    const int n = un & 63, h = (un >> 6) & 7, b = un >> 9;
    const size_t tok0 = (size_t)b * SEQ + (size_t)n * 64;
    f32x4 wq[8];
    if (part < 3) { const int ch = part * 1024 + h * 128 + 8 * o;
#pragma unroll
        for (int k = 0; k < 4; ++k) { wq[2 * k] = *(const f32x4*)(convw + (size_t)k * 3072 + ch); wq[2 * k + 1] = *(const f32x4*)(convw + (size_t)k * 3072 + ch + 4); } }
    BAR_LDS();
    if (tid < 64) {
        const float beta = 1.0f / (1.0f + expf(-braw));
        const float xx = araw + dtb[h];
        const float sp = fmaxf(xx, 0.f) + log1pf(expf(-fabsf(xx)));
        float g = -expf(alog[h]) * sp;
#pragma unroll
        for (int o2 = 1; o2 < 64; o2 <<= 1) { const float t = __shfl_up(g, o2); if (lane >= o2) g += t; }
        gcs[tid] = g; betas[tid] = beta;
    }
    for (int i = tid; i < 64 * 68; i += 512) Tf[i] = 0.f;
    BAR_LDS();
    const float gl = gcs[63];
    {
        if (part < 3) {
            float y[8][8];
#pragma unroll
            for (int i = 0; i < 8; ++i) {
#pragma unroll
                for (int c = 0; c < 8; ++c) {
                    float acc = 0.f;
#pragma unroll
                    for (int k = 0; k < 4; ++k) { const unsigned u = xr[i + k][c >> 1]; acc += wq[2 * k + (c >> 2)][c & 3] * ((c & 1) ? bf_hi(u) : bf_lo(u)); }
                    y[i][c] = silu_f(acc);
                }
            }
            if (part < 2) {
#pragma unroll
                for (int i = 0; i < 8; ++i) {
                    float ss = 0.f;
#pragma unroll
                    for (int c = 0; c < 8; ++c) ss += y[i][c] * y[i][c];
                    ss = row16_sum(ss);
                    const float rn = rsqrtf(ss + 1e-6f) * (part == 0 ? 0.08838834764831845f : 1.0f);
#pragma unroll
                    for (int c = 0; c < 8; ++c) y[i][c] *= rn;
                }
            }
            if (part == 0) {
                bf16_t* QD = (bf16_t*)(ws + WS_QD) + (size_t)un * 8192;
#pragma unroll
                for (int i = 0; i < 8; ++i) {
                    const int tk = 8 * tg + i; const float eg = fexp(gcs[tk]);
                    u32x4 w; w.x = pk2(y[i][0], y[i][1]); w.y = pk2(y[i][2], y[i][3]); w.z = pk2(y[i][4], y[i][5]); w.w = pk2(y[i][6], y[i][7]);
                    *(LAS u32x4*)(sm + OFF_QS + tk * RB + 16 * o) = w;
                    u32x4 d; d.x = pk2(y[i][0] * eg, y[i][1] * eg); d.y = pk2(y[i][2] * eg, y[i][3] * eg); d.z = pk2(y[i][4] * eg, y[i][5] * eg); d.w = pk2(y[i][6] * eg, y[i][7] * eg);
                    *(u32x4*)(QD + (((((tk >> 5) * 8 + (o >> 1)) * 64) + (tk & 31) + 32 * (o & 1)) << 3)) = d;
                }
            } else if (part == 1) {
                bf16_t* KDT = (bf16_t*)(ws + WS_KDT) + (size_t)un * 8192;
                float f1[8], f2[8];
#pragma unroll
                for (int i = 0; i < 8; ++i) { const int tk = 8 * tg + i; const float gi = gcs[tk]; f1[i] = betas[tk] * fexp(gi); f2[i] = fexp(gl - gi);
                    u32x4 w; w.x = pk2(y[i][0], y[i][1]); w.y = pk2(y[i][2], y[i][3]); w.z = pk2(y[i][4], y[i][5]); w.w = pk2(y[i][6], y[i][7]);
                    *(LAS u32x4*)(sm + OFF_KS + tk * RB + 16 * o) = w; }
#pragma unroll
                for (int c = 0; c < 8; ++c) {
                    u32x4 w; w.x = pk2(y[0][c] * f1[0], y[1][c] * f1[1]); w.y = pk2(y[2][c] * f1[2], y[3][c] * f1[3]); w.z = pk2(y[4][c] * f1[4], y[5][c] * f1[5]); w.w = pk2(y[6][c] * f1[6], y[7][c] * f1[7]);
                    *(LAS u32x4*)(sm + OFF_KBT + (8 * o + c) * TB + 16 * tg) = w;
                    u32x4 d; d.x = pk2(y[0][c] * f2[0], y[1][c] * f2[1]); d.y = pk2(y[2][c] * f2[2], y[3][c] * f2[3]); d.z = pk2(y[4][c] * f2[4], y[5][c] * f2[5]); d.w = pk2(y[6][c] * f2[6], y[7][c] * f2[7]);
                    { const int dk = 8 * o + c; *(u32x4*)(KDT + (((((dk >> 5) * 4 + (tg >> 1)) * 64) + (dk & 31) + 32 * (tg & 1)) << 3)) = d; }
                }
            } else {
                float f1[8];
#pragma unroll
                for (int i = 0; i < 8; ++i) f1[i] = betas[8 * tg + i];
#pragma unroll
                for (int c = 0; c < 8; ++c) {
                    u32x4 w; w.x = pk2(y[0][c] * f1[0], y[1][c] * f1[1]); w.y = pk2(y[2][c] * f1[2], y[3][c] * f1[3]); w.z = pk2(y[4][c] * f1[4], y[5][c] * f1[5]); w.w = pk2(y[6][c] * f1[6], y[7][c] * f1[7]);
                    *(LAS u32x4*)(sm + OFF_VBT + (8 * o + c) * TB + 16 * tg) = w;
                }
            }
        }
    }
    __syncthreads();
    { const int nu = un + (int)gridDim.x; if (nu < 2048) CHUNK_PREFETCH(nu); }
    {
        const int mat = wid >> 2, bi = (wid & 3) >> 1, bj = wid & 1;
        f32x16 s;
#pragma unroll
        for (int r = 0; r < 16; ++r) s[r] = 0.f;
#pragma unroll
        for (int jh = 0; jh < 2; ++jh) {
            bf16x8 af[4], bf[4];
#pragma unroll
            for (int j = 0; j < 4; ++j) {
                af[j] = *(const LAS bf16x8*)(sm + (mat ? OFF_QS : OFF_KS) + (32 * bi + r32) * RB + (16 * (4 * jh + j) + 8 * hi) * 2);
                bf[j] = *(const LAS bf16x8*)(sm + OFF_KS + (32 * bj + r32) * RB + (16 * (4 * jh + j) + 8 * hi) * 2);
            }
#pragma unroll
            for (int j = 0; j < 4; ++j) s = MFMA32(af[j], bf[j], s);
        }
        const int jj = 32 * bj + r32; const float gj = gcs[jj];
        bf16_t* AQK = (bf16_t*)(ws + WS_AQK) + (size_t)un * 4096;
#pragma unroll
        for (int r = 0; r < 16; ++r) {
            const int ii = 32 * bi + crow(r, hi);
            const float dec = fexp(fminf(gcs[ii] - gj, 0.f));
            if (mat == 0) Lf[ii * 65 + jj] = (ii > jj) ? betas[ii] * s[r] * dec : 0.f;
            else AQK[((((ii >> 5) * 4 + (jj >> 4)) * 64 + (ii & 31) + 32 * ((jj >> 3) & 1)) << 3) + (jj & 7)] = (bf16_t)(pk2((ii >= jj) ? s[r] * dec : 0.f, 0.f) & 0xffffu);
        }
    }
    __syncthreads();
    if (tid < 64) {
        const int I = tid >> 4, c = tid & 15;
        float x[16];
#pragma unroll
        for (int i = 0; i < 16; ++i) {
            float v = (i == c) ? 1.f : 0.f;
#pragma unroll
            for (int j = 0; j < i; ++j) v -= Lf[(16 * I + i) * 65 + 16 * I + j] * x[j];
            x[i] = v;
        }
#pragma unroll
        for (int i = 0; i < 16; ++i) Tf[(16 * I + i) * 68 + 16 * I + c] = x[i];
    }
    __syncthreads();
#pragma nounroll
    for (int I = 1; I < 4; ++I) {
        const int ng = 4 * I;
        if (tid < 16 * ng) {
            const int i = tid / ng, c4 = (tid % ng) * 4;
            f32x4 acc = {0.f, 0.f, 0.f, 0.f};
            const LAS float* lrow = Lf + (16 * I + i) * 65;
#pragma unroll 8
            for (int k = 0; k < 16 * I; ++k) acc += *(const LAS f32x4*)(Tf + k * 68 + c4) * lrow[k];
            *(LAS f32x4*)(Mf + i * 68 + c4) = acc;
        }
        __syncthreads();
        if (tid < 16 * ng) {
            const int i = tid / ng, c4 = (tid % ng) * 4;
            f32x4 acc = {0.f, 0.f, 0.f, 0.f};
            const LAS float* drow = Tf + (16 * I + i) * 68 + 16 * I;
#pragma unroll
            for (int k = 0; k < 16; ++k) acc += *(const LAS f32x4*)(Mf + k * 68 + c4) * drow[k];
            *(LAS f32x4*)(Tf + (16 * I + i) * 68 + c4) = -acc;
        }
        __syncthreads();
    }
    for (int e = tid; e < 64 * 32; e += 512) {
        const int i = e >> 5, j2 = (e & 31) * 2;
        *(LAS unsigned*)(sm + OFF_TBF + i * TB + j2 * 2) = pk2(Tf[i * 68 + j2], Tf[i * 68 + j2 + 1]);
    }
    __syncthreads();
    {
        const int mat = wid >> 2, bi = (wid & 3) >> 1;
        float* U = (float*)(ws + WS_U);
        bf16_t* WG = (bf16_t*)(ws + WS_WG) + (size_t)un * 8192;
#pragma unroll
        for (int cc = 0; cc < 2; ++cc) {
            const int bc = 2 * (wid & 1) + cc;
            f32x16 s;
#pragma unroll
            for (int r = 0; r < 16; ++r) s[r] = 0.f;
            {
                bf16x8 af[4], bf[4];
#pragma unroll
                for (int k = 0; k < 4; ++k) {
                    af[k] = *(const LAS bf16x8*)(sm + OFF_TBF + (32 * bi + r32) * TB + (16 * k + 8 * hi) * 2);
                    bf[k] = *(const LAS bf16x8*)(sm + (mat ? OFF_KBT : OFF_VBT) + (32 * bc + r32) * TB + (16 * k + 8 * hi) * 2);
                }
#pragma unroll
                for (int k = 0; k < 4; ++k) s = MFMA32(af[k], bf[k], s);
            }
            if (mat == 0) {
                f32x4* dst = (f32x4*)(U + (((size_t)un * 2 + bi) * 4 + bc) * 1024 + lane * 16);
#pragma unroll
                for (int q = 0; q < 4; ++q) dst[q] = (f32x4){s[4 * q], s[4 * q + 1], s[4 * q + 2], s[4 * q + 3]};
            }
#pragma unroll
            for (int r = 0; r < 16; ++r) {
                const int ii = 32 * bi + crow(r, hi), c = 32 * bc + r32;
                if (mat == 0) {}
                else WG[((((ii >> 5) * 8 + (c >> 4)) * 64 + (ii & 31) + 32 * ((c >> 3) & 1)) << 3) + (c & 7)] = (bf16_t)(pk2(s[r], 0.f) & 0xffffu);
            }
        }
    }
    if (tid == 0) ((float*)(ws + WS_CD))[un] = expf(gcs[63]);
    }
#undef CHUNK_PREFETCH
}

constexpr int OFF_ST = 0, OFF_VN = 32 * RB;
__device__ __forceinline__ void scan_task(int task, unsigned char* ws, bf16_t* OB, lptr sm) {
    const int tid = opaque_tid(), lane = tid & 63, wid = __builtin_amdgcn_readfirstlane(tid >> 6), r32 = lane & 31, hi = lane >> 5;
    const int bh = task >> 2, sl = task & 3, b = bh >> 3, h = bh & 7, e0 = 32 * sl;
    const int role = wid < 2 ? 0 : (wid < 4 ? 1 : 2);
    const int rb = wid < 2 ? wid : (wid < 4 ? wid - 2 : wid - 4);
    const bf16_t* WG = (const bf16_t*)(ws + WS_WG); const bf16_t* QD = (const bf16_t*)(ws + WS_QD); const bf16_t* KDT = (const bf16_t*)(ws + WS_KDT);
    const bf16_t* AQK = (const bf16_t*)(ws + WS_AQK); float* U = (float*)(ws + WS_U); const float* CD = (const float*)(ws + WS_CD);
    __syncthreads();
    for (int i = tid; i < (32 * RB + 32 * TB) / 4; i += 512) ((LAS unsigned*)sm)[i] = 0u;
    f32x16 Sacc;
#pragma unroll
    for (int r = 0; r < 16; ++r) Sacc[r] = 0.f;
    bf16x8 faA[8], faB[8], faC[8]; u32x4 fxA[4], fxB[4], fxC[4];
    const size_t ubase = ((size_t)b * SEQ + 32 * rb + 4 * hi) * DM + h * 128 + e0 + r32;
    const size_t abase = (size_t)bh * 64 * 8192 + ((size_t)rb * 512 + lane) * 8;
    const size_t kbase = (size_t)bh * 64 * 8192 + ((size_t)rb * 256 + lane) * 8;
    const size_t qbase = (size_t)bh * 64 * 4096 + ((size_t)rb * 256 + lane) * 8;
#define NCL(nn) ((nn) < 63 ? (nn) : 63)
#define LOAD_R0(nn, FA, FX) do { const int n_ = NCL(nn); \
        _Pragma("unroll") for (int j = 0; j < 8; ++j) FA[j] = *(const bf16x8*)(WG + abase + (size_t)n_ * 8192 + 512 * j); \
        { const u32x4* us_ = (const u32x4*)(U + ((((size_t)bh * 64 + n_) * 2 + rb) * 4 + sl) * 1024 + lane * 16); _Pragma("unroll") for (int q = 0; q < 4; ++q) FX[q] = us_[q]; } } while (0)
#define LOAD_R1(nn, FA, FX) do { const int n_ = NCL(nn); \
        _Pragma("unroll") for (int j = 0; j < 8; ++j) FA[j] = *(const bf16x8*)(QD + abase + (size_t)n_ * 8192 + 512 * j); \
        _Pragma("unroll") for (int j = 0; j < 4; ++j) FX[j] = *(const u32x4*)(AQK + qbase + (size_t)n_ * 4096 + 512 * j); } while (0)
#define LOAD_R2(nn, FA, FX) do { const int n_ = NCL(nn); \
        _Pragma("unroll") for (int j = 0; j < 4; ++j) FA[j] = *(const bf16x8*)(KDT + kbase + (size_t)n_ * 8192 + 512 * j); FX[0][0] = __float_as_uint(CD[(size_t)bh * 64 + n_]); } while (0)
#define STEP_R0(nn, FA, FX, LFA, LFX) do { LOAD_R0((nn) + 2, LFA, LFX); \
        f32x16 acc; _Pragma("unroll") for (int r = 0; r < 16; ++r) acc[r] = 0.f; \
        _Pragma("unroll") for (int j = 0; j < 8; ++j) { const bf16x8 sb = *(const LAS bf16x8*)(sm + OFF_ST + r32 * RB + (16 * j + 8 * hi) * 2); acc = MFMA32(FA[j], sb, acc); } \
        _Pragma("unroll") for (int g = 0; g < 4; ++g) { \
            u32x2 w; w.x = pk2(__uint_as_float(FX[g][0]) - acc[4 * g], __uint_as_float(FX[g][1]) - acc[4 * g + 1]); w.y = pk2(__uint_as_float(FX[g][2]) - acc[4 * g + 2], __uint_as_float(FX[g][3]) - acc[4 * g + 3]); \
            *(LAS u32x2*)(sm + OFF_VN + r32 * TB + 2 * (32 * rb + 8 * g + 4 * hi)) = w; } \
        BAR_LDS(); BAR_LDS(); } while (0)
#define STEP_R1(nn, FA, FX, LFA, LFX) do { LOAD_R1((nn) + 2, LFA, LFX); \
        f32x16 acc; _Pragma("unroll") for (int r = 0; r < 16; ++r) acc[r] = 0.f; \
        _Pragma("unroll") for (int j = 0; j < 8; ++j) { const bf16x8 sb = *(const LAS bf16x8*)(sm + OFF_ST + r32 * RB + (16 * j + 8 * hi) * 2); acc = MFMA32(FA[j], sb, acc); } \
        BAR_LDS(); \
        _Pragma("unroll") for (int k = 0; k < 4; ++k) { const bf16x8 vb = *(const LAS bf16x8*)(sm + OFF_VN + r32 * TB + (16 * k + 8 * hi) * 2); acc = MFMA32(__builtin_bit_cast(bf16x8, FX[k]), vb, acc); } \
        _Pragma("unroll") for (int r = 0; r < 16; r += 2) { const unsigned w_ = pk2(acc[r], acc[r + 1]); OB[ubase + (size_t)((nn) * 64 + (r & 3) + 8 * (r >> 2)) * DM] = (bf16_t)(w_ & 0xffffu); OB[ubase + (size_t)((nn) * 64 + ((r + 1) & 3) + 8 * ((r + 1) >> 2)) * DM] = (bf16_t)(w_ >> 16); } \
        BAR_LDS(); } while (0)
#define STEP_R2(nn, FA, FX, LFA, LFX) do { LOAD_R2((nn) + 2, LFA, LFX); \
        BAR_LDS(); \
        Sacc = Sacc * __uint_as_float(FX[0][0]); \
        _Pragma("unroll") for (int k = 0; k < 4; ++k) { const bf16x8 vb = *(const LAS bf16x8*)(sm + OFF_VN + r32 * TB + (16 * k + 8 * hi) * 2); Sacc = MFMA32(FA[k], vb, Sacc); } \
        _Pragma("unroll") for (int g = 0; g < 4; ++g) { u32x2 w; w.x = pk2(Sacc[4 * g], Sacc[4 * g + 1]); w.y = pk2(Sacc[4 * g + 2], Sacc[4 * g + 3]); \
            *(LAS u32x2*)(sm + OFF_ST + r32 * RB + 2 * (32 * rb + 8 * g + 4 * hi)) = w; } \
        BAR_LDS(); } while (0)
#define ROLE_LOOP(LOADM, STEPM) do { LOADM(0, faA, fxA); LOADM(1, faB, fxB); BAR_LDS(); \
        _Pragma("nounroll") for (int n = 0; n < 64; n += 3) { STEPM(n, faA, fxA, faC, fxC); if (n + 1 < 64) { STEPM(n + 1, faB, fxB, faA, fxA); STEPM(n + 2, faC, fxC, faB, fxB); } } } while (0)
    if (role == 0) ROLE_LOOP(LOAD_R0, STEP_R0);
    else if (role == 1) ROLE_LOOP(LOAD_R1, STEP_R1);
    else ROLE_LOOP(LOAD_R2, STEP_R2);
#undef NCL
#undef LOAD_R0
#undef LOAD_R1
#undef LOAD_R2
#undef STEP_R0
#undef STEP_R1
#undef STEP_R2
#undef ROLE_LOOP
}

__device__ __forceinline__ void post_phase(const bf16_t* O, const bf16_t* P, const float* nw, bf16_t* H) {
    const int tid = opaque_tid(), lane = tid & 63, wave = tid >> 6;
    const int gw = blockIdx.x * 8 + wave, NGW = gridDim.x * 8;
    const f32x4 wv = *(const f32x4*)(nw + ((4 * lane) & 127));
    for (int m = gw; m < M; m += NGW) {
        const u32x2* orow = (const u32x2*)(O + (size_t)m * DM) + lane;
        const u32x2* grow = (const u32x2*)(P + (size_t)m * PLD + 3072) + lane;
        u32x2* hrow = (u32x2*)(H + (size_t)m * DM) + lane;
#pragma unroll
        for (int j = 0; j < 4; ++j) {
            const u32x2 ov = orow[64 * j]; const f32x4 v = {bf_lo(ov.x), bf_hi(ov.x), bf_lo(ov.y), bf_hi(ov.y)}; const u32x2 gq = grow[64 * j];
            float ss = (v[0] * v[0] + v[1] * v[1]) + (v[2] * v[2] + v[3] * v[3]);
            ss = x16_sum(row16_sum(ss));
            const float rs = rsqrtf(ss * (1.0f / 128.0f) + RMS_EPS);
            u32x2 o; o.x = pk2(v[0] * rs * wv[0] * silu_f(bf_lo(gq.x)), v[1] * rs * wv[1] * silu_f(bf_hi(gq.x)));
            o.y = pk2(v[2] * rs * wv[2] * silu_f(bf_lo(gq.y)), v[3] * rs * wv[3] * silu_f(bf_hi(gq.y)));
            hrow[64 * j] = o;
        }
    }
}
}


#define GAS __attribute__((address_space(1)))
#define XB_TMO      32
#define XB_XCNT(j)  (64   + 32 * (j))
#define XB_XSUB(j)  (576  + 32 * (j))
#define XB_XGEN(j)  (1088 + 32 * (j))
#define XB_TOP      1600
#define XB_TOPGEN   1632
#define XCD_BAR_WORDS 1664
#define XB_SPIN_CAP (1u << 18)

__device__ __forceinline__ unsigned xb_ld(unsigned* p)              { return __hip_atomic_load(p, __ATOMIC_RELAXED, __HIP_MEMORY_SCOPE_AGENT); }
__device__ __forceinline__ unsigned xb_add(unsigned* p, unsigned v) { return __hip_atomic_fetch_add(p, v, __ATOMIC_RELAXED, __HIP_MEMORY_SCOPE_AGENT); }
__device__ __forceinline__ unsigned xb_xcc_id() { return (unsigned)__builtin_amdgcn_s_getreg((3 << 11) | 20) & 0xFu; }
#define XB_SPIN(cond, bar) do { unsigned _sp = 0; while (cond) { __builtin_amdgcn_s_sleep(1); \
    if ((++_sp & 255u) == 0u) { if (xb_ld(&(bar)[XB_TMO])) break; if (_sp > XB_SPIN_CAP) { atomicAdd(&(bar)[XB_TMO], 1u); break; } } } } while (0)

struct XcdBarrier {
    unsigned* bar; unsigned x;
    volatile LAS unsigned* st;
};

__device__ __forceinline__ XcdBarrier xcd_barrier_post(unsigned* bar, volatile LAS unsigned* st) {
    XcdBarrier b; b.bar = bar; b.x = xb_xcc_id(); b.st = st;
    if (threadIdx.x == 0) (void)xb_add(&bar[XB_XCNT(b.x)], 1u);
    return b;
}
__device__ __forceinline__ void xcd_barrier_complete(unsigned* bar, unsigned x, unsigned& nloc, unsigned& nx) {
    const unsigned G = gridDim.x * gridDim.y * gridDim.z;
    unsigned sum, cnt, mine, sp = 0u;
    for (;;) {
        sum = 0u; cnt = 0u; mine = 0u;
#pragma unroll
        for (unsigned j = 0; j < 16; ++j) { const unsigned c = xb_ld(&bar[XB_XCNT(j)]); sum += c; cnt += (c > 0u) ? 1u : 0u; mine = (j == x) ? c : mine; }
        if (sum == G) break;
        __builtin_amdgcn_s_sleep(1);
        if ((++sp & 255u) == 0u) { if (xb_ld(&bar[XB_TMO])) break; if (sp > XB_SPIN_CAP) { atomicAdd(&bar[XB_TMO], 1u); break; } }
    }
    nloc = mine > 0u ? mine : 1u; nx = cnt > 0u ? cnt : 1u;
}

__device__ __forceinline__ void xcd_barrier(const XcdBarrier& b) {
    asm volatile("s_waitcnt vmcnt(0)" ::: "memory");
    __syncthreads();
    if (threadIdx.x == 0) {
        unsigned* bar = b.bar;
        __builtin_amdgcn_s_waitcnt(0);
        unsigned nloc = b.st[0], nx = b.st[1];
        if (nloc == 0u) { xcd_barrier_complete(bar, b.x, nloc, nx); b.st[0] = nloc; b.st[1] = nx; }
        const unsigned old = xb_add(&bar[XB_XSUB(b.x)], 1u);
        const unsigned gen = old / nloc;
        if (old + 1u == (gen + 1u) * nloc) {
            __builtin_amdgcn_fence(__ATOMIC_RELEASE, "agent");
            asm volatile("s_waitcnt vmcnt(0)" ::: "memory");
            const unsigned og = xb_add(&bar[XB_TOP], 1u);
            const unsigned tg = og / nx;
            if (og + 1u == (tg + 1u) * nx) xb_add(&bar[XB_TOPGEN], 1u);
            else XB_SPIN(xb_ld(&bar[XB_TOPGEN]) == tg, bar);
            __builtin_amdgcn_fence(__ATOMIC_ACQUIRE, "agent");
            xb_add(&bar[XB_XGEN(b.x)], 1u);
            asm volatile("s_waitcnt vmcnt(0)" ::: "memory");
        } else {
            XB_SPIN(xb_ld(&bar[XB_XGEN(b.x)]) == gen, bar);
            __builtin_amdgcn_fence(__ATOMIC_ACQUIRE, "agent");
            asm volatile("s_waitcnt vmcnt(0)" ::: "memory");
        }
    }
    __syncthreads();
}
#ifndef PM
#define PM 0xFFFF
#endif
#define GSYNC() do { xcd_barrier(xbar); if (PROBE & 0x1000) xcd_barrier(xbar); } while (0)
__global__ void __launch_bounds__(512, 2) fwd_megakernel(Params p) {
    cg::grid_group grid = cg::this_grid();
    grid.sync();
    const lptr lds = (lptr)lds_raw;
    volatile LAS unsigned* xst = (volatile LAS unsigned*)(lds + 139264);
    if (threadIdx.x == 0) { xst[0] = 0u; xst[1] = 0u; }
    __syncthreads();
    XcdBarrier xbar = xcd_barrier_post((unsigned*)(p.ws + WS_BAR), xst);
    unsigned char* ws = p.ws;
    bf16_t* H = (bf16_t*)p.out;
    bf16_t* XB = (bf16_t*)(ws + WS_H);
    bf16_t* PROJ = (bf16_t*)(ws + WS_R1);
    bf16_t* HID = (bf16_t*)(ws + WS_HID);
    float* ABv = (float*)(ws + WS_AB);
    float* SS = (float*)(ws + WS_SS);
#pragma nounroll
    for (int l = 0; l < 4; ++l) {
        const bool odd = l & 1; const int e = l >> 1;
#pragma nounroll
        for (int sbk = 0; sbk < 3; ++sbk) {
            const int ni = 3 * l + sbk;
            if (sbk != 1) {
                if (sbk == 0 && l == 0) {
                    convert_layer(p, 0, lds, 1, 0); __syncthreads();
                    prologue_phase(p.in[0], XB, SS);
                    GSYNC();
                }
                for (int rp = 0; rp < REPS(4); ++rp) { EpiSwiGLU E{HID, DFF, SS + (size_t)(ni & 1) * M * 16}; run_gemm(lds, XB, (const bf16_t*)(ws + (sbk == 0 ? WS_WGU1 : WS_WGU2)), 2 * DFF, DM, E); }
                if ((int)blockIdx.x >= (int)gridDim.x / 2) {
                    if (sbk == 0) convert_layer(p, l, lds, 2, (int)gridDim.x / 2);
                    else if (l < 3) convert_layer(p, l + 1, lds, 1, (int)gridDim.x / 2);
                }
                GSYNC();
                { EpiResid<true> E{XB, SS + (size_t)((ni + 1) & 1) * M * 16}; run_gemm(lds, HID, (const bf16_t*)(ws + (sbk == 0 ? WS_WD1 : WS_WD2)), DM, DFF, E); }
                GSYNC();
            } else {
                const float* nw = p.in[5] + (size_t)l * DM;
                if (odd) ab_phase(XB, nw, SS + (size_t)(ni & 1) * M * 16, p.in[10] + (size_t)e * DM * 4112 + 4096, ABv, lds);
                for (int rp = 0; rp < REPS(4); ++rp) { const int nin = odd ? 4096 : 3072; EpiBf16 E{PROJ, nin, SS + (size_t)(ni & 1) * M * 16}; run_gemm(lds, XB, (const bf16_t*)(ws + WS_WIN), nin, DM, E); }
                GSYNC();
                if (!odd) {
                    att::phase(PROJ, H, p.in[7] + (size_t)e * 256, p.in[8] + (size_t)e * 128, l, (unsigned*)(ws + WS_BAR + 14336) + 64 * e, lds);
                } else {
                    gdn::chunk_phase(PROJ, ABv, p.in[11] + (size_t)e * 4 * 3072, p.in[12] + e * 8, p.in[13] + e * 8, ws, lds);
                    GSYNC();
                    for (int rp = 0; rp < REPS(128); ++rp) for (int t = blockIdx.x; t < 128; t += gridDim.x) gdn::scan_task((((t & 7) * 4 + (t >> 5)) << 2) | ((t >> 3) & 3), ws, H, lds);
                    GSYNC();
                    gdn::post_phase(H, PROJ, p.in[14] + e * 128, H);
                }
                GSYNC();
                { EpiResid<false> E{XB, SS + (size_t)((ni + 1) & 1) * M * 16}; run_gemm(lds, H, (const bf16_t*)(ws + WS_WOUT), DM, DM, E); }
                GSYNC();
            }
        }
    }
    final_norm_phase(XB, p.out, p.in[20]);
}

extern "C" void kernel_launch(void* const* d_in, const int* in_sizes, int n_in, void* d_out, int out_size, void* d_ws, size_t ws_size, hipStream_t stream) {
    static int grid = 0;
    if (grid == 0) {
        if (n_in != 21 || out_size != M * DM || ws_size < WS_END) { fprintf(stderr, "kernel_launch: unexpected shapes (n_in %d out %d ws %zu, need %zu)\n", n_in, out_size, ws_size, (size_t)WS_END); grid = -1; return; }
        int dev = 0, cus = 0, per_cu = 0;
        hipGetDevice(&dev);
        hipDeviceGetAttribute(&cus, hipDeviceAttributeMultiprocessorCount, dev);
        if (hipFuncSetAttribute((const void*)fwd_megakernel, hipFuncAttributeMaxDynamicSharedMemorySize, LDS_BYTES) != hipSuccess) { fprintf(stderr, "kernel_launch: hipFuncSetAttribute failed\n"); grid = -1; return; }
        if (hipOccupancyMaxActiveBlocksPerMultiprocessor(&per_cu, (const void*)fwd_megakernel, 512, LDS_BYTES) != hipSuccess || per_cu < 1) { fprintf(stderr, "kernel_launch: occupancy query gave %d\n", per_cu); per_cu = 1; }
        (void)hipGetLastError();
        grid = cus * 1;
        if (grid > 256) grid = 256;
    }
    if (grid < 0) return;
    if (hipMemsetAsync((char*)d_ws + WS_BAR, 0, 16384, stream) != hipSuccess) { fprintf(stderr, "kernel_launch: memset failed\n"); return; }
    Params p{};
    for (int i = 0; i < 21; ++i) p.in[i] = (const float*)d_in[i];
    p.out = (float*)d_out; p.ws = (unsigned char*)d_ws;
    void* args[] = {&p};
    hipError_t e = hipLaunchCooperativeKernel((const void*)fwd_megakernel, dim3(grid), dim3(512), args, LDS_BYTES, stream);
    if (e != hipSuccess) fprintf(stderr, "cooperative launch failed: %s (grid %d)\n", hipGetErrorString(e), grid);
}
```
